# Optimizing an MI355X kernel written in HIP

```python
import jax, jax.numpy as jnp
from jax import lax
import numpy as np

D_MODEL = 2048
BATCH = 8
SEQ = 2048
DEPTH = 1

N_META = 16
RMS_EPS = 1e-6
HEAD_DIM = 128
ATT_Q_HEADS = 8
ATT_KV_HEADS = 2
ATT_GROUP = ATT_Q_HEADS // ATT_KV_HEADS
WINDOW = 128
ATT_BLOCK = 128
ROPE_THETA = 500000.0
ROPE_DIM = HEAD_DIM // 4
HGRN_HEADS = 8
HGRN_DK = 128
HGRN_DV = 128
HGRN_CHUNK = 64
ATT_WIDTH = ATT_Q_HEADS * HEAD_DIM
HGRN_WIDTH = HGRN_HEADS * HGRN_DV
MIX_WIDTH = ATT_WIDTH + HGRN_WIDTH
Q_COLS = ATT_Q_HEADS * HEAD_DIM
KV_COLS = ATT_KV_HEADS * HEAD_DIM
HK = HGRN_HEADS * HGRN_DK
HV = HGRN_HEADS * HGRN_DV
IN_SPLITS = [Q_COLS, KV_COLS, KV_COLS, HK, HK, HV, HV]
IN_COLS = sum(IN_SPLITS)
PEER_HEADS = 8
PEER_NKEYS = 128
PEER_N = PEER_NKEYS * PEER_NKEYS
PEER_DKEY = 256
PEER_DHALF = PEER_DKEY // 2
PEER_TOPK = 16
PEER_TOKEN_BLOCK = 128

kernel_name = "hymba_swa_sink_hgrn2_peer_block"


def rms_norm(x, g):
    xf = x.astype(jnp.float32)
    y = xf * lax.rsqrt(jnp.mean(xf * xf, axis=-1, keepdims=True) + RMS_EPS)
    return (y * g.astype(jnp.float32)).astype(x.dtype)


def partial_rope(x, pos):
    half = ROPE_DIM // 2
    inv = ROPE_THETA ** (-jnp.arange(0, ROPE_DIM, 2, dtype=jnp.float32) / ROPE_DIM)
    ang = pos.astype(jnp.float32)[:, None] * inv[None, :]
    cos = jnp.cos(ang)[None, :, None, :]
    sin = jnp.sin(ang)[None, :, None, :]
    xr = x[..., :ROPE_DIM].astype(jnp.float32)
    x1, x2 = xr[..., :half], xr[..., half:]
    rot = jnp.concatenate([x1 * cos - x2 * sin, x2 * cos + x1 * sin], axis=-1)
    return jnp.concatenate([rot.astype(x.dtype), x[..., ROPE_DIM:]], axis=-1)


def sliding_window_sink_attention(q, k, v, sinks):
    B, L = q.shape[0], q.shape[1]
    pad = ATT_BLOCK - N_META
    Lp = L + pad
    nb = Lp // ATT_BLOCK
    padw = ((0, 0), (pad, 0), (0, 0), (0, 0))
    qb = jnp.pad(q, padw).reshape(B, nb, ATT_BLOCK, ATT_KV_HEADS, ATT_GROUP, HEAD_DIM)
    kb = jnp.pad(k, padw).reshape(B, nb, ATT_BLOCK, ATT_KV_HEADS, HEAD_DIM)
    vb = jnp.pad(v, padw).reshape(B, nb, ATT_BLOCK, ATT_KV_HEADS, HEAD_DIM)

    def with_meta_and_band(t, tb):
        prev = jnp.concatenate([jnp.zeros_like(tb[:, :1]), tb[:, :-1]], axis=1)
        meta = jnp.broadcast_to(t[:, None, :N_META], (B, nb, N_META, ATT_KV_HEADS, HEAD_DIM))
        return jnp.concatenate([meta, prev, tb], axis=2)

    keys = with_meta_and_band(k, kb)
    vals = with_meta_and_band(v, vb)
    qpos = (jnp.arange(Lp) - pad).reshape(nb, ATT_BLOCK)
    kpos = jnp.concatenate([qpos - ATT_BLOCK, qpos], axis=-1)
    rel = qpos[:, :, None] - kpos[:, None, :]
    band_mask = (rel >= 0) & (rel < WINDOW) & (kpos[:, None, :] >= N_META)
    meta_mask = jnp.arange(N_META)[None, None, :] <= qpos[:, :, None]
    mask = jnp.concatenate([meta_mask, band_mask], axis=-1)

    scale = HEAD_DIM ** -0.5
    scores = jnp.einsum('bnqhgd,bnkhd->bhgnqk', qb, keys).astype(jnp.float32) * scale
    scores = jnp.where(mask, scores, -jnp.inf)
    sink = jnp.broadcast_to(sinks.astype(jnp.float32).reshape(1, ATT_KV_HEADS, ATT_GROUP, 1, 1, 1),
                            scores.shape[:-1] + (1,))
    probs = jax.nn.softmax(jnp.concatenate([scores, sink], axis=-1), axis=-1)[..., :-1]
    out = jnp.einsum('bhgnqk,bnkhd->bnqhgd', probs.astype(v.dtype), vals)
    return out.reshape(B, Lp, ATT_WIDTH)[:, pad:]


def _hgrn2_chunk_step(state, inp):
    q, lf, kk, v = inp
    C = q.shape[2]
    b = jnp.cumsum(lf, axis=2)
    causal = jnp.tril(jnp.ones((C, C), dtype=bool))
    diff = b[:, :, :, None, :] - b[:, :, None, :, :]
    decay = jnp.exp(jnp.where(causal[None, None, :, :, None], diff, -jnp.inf))
    scores = jnp.einsum('bhtsk,bhsk->bhts', q[:, :, :, None, :] * decay, kk)
    o = (jnp.einsum('bhts,bhsv->bhtv', scores, v)
         + jnp.einsum('bhtk,bhkv->bhtv', q * jnp.exp(b), state))
    b_last = b[:, :, -1:, :]
    new_state = (jnp.exp(b_last[:, :, 0, :])[..., None] * state
                 + jnp.einsum('bhsk,bhsv->bhkv', kk * jnp.exp(b_last - b), v))
    return new_state, o


def hgrn2_mixer(hq, hf, hi, hg, lb, norm_g):
    B, L = hq.shape[0], hq.shape[1]
    out_dtype = hi.dtype
    lbf = lb.astype(jnp.float32)
    z = hf.astype(jnp.float32)
    logf = jnp.log(lbf + (1.0 - lbf) * jax.nn.sigmoid(z))
    kgate = (1.0 - lbf) * jax.nn.sigmoid(-z)
    q = jax.nn.silu(hq.astype(jnp.float32))
    v = hi.astype(jnp.float32)
    pad = HGRN_CHUNK - N_META
    Lp = L + pad
    nc = Lp // HGRN_CHUNK

    def chunks(t, d):
        t = jnp.pad(t, ((0, 0), (pad, 0), (0, 0)))
        return t.reshape(B, nc, HGRN_CHUNK, HGRN_HEADS, d).transpose(1, 0, 3, 2, 4)

    xs = (chunks(q, HGRN_DK), chunks(logf, HGRN_DK), chunks(kgate, HGRN_DK), chunks(v, HGRN_DV))
    s0 = jnp.zeros((B, HGRN_HEADS, HGRN_DK, HGRN_DV), jnp.float32)
    _, o = lax.scan(_hgrn2_chunk_step, s0, xs)
    o = o.transpose(1, 0, 3, 2, 4).reshape(B, Lp, HGRN_HEADS, HGRN_DV)[:, pad:]
    o = rms_norm(o, norm_g.reshape(HGRN_HEADS, HGRN_DV)).reshape(B, L, HV)
    return (o * jax.nn.silu(hg.astype(jnp.float32))).astype(out_dtype)


def peer_ffn(x, w_q, sub_keys, u, v):
    B, S, D = x.shape
    T = B * S
    xt = x.reshape(T, D)
    q = (xt @ w_q).reshape(T, PEER_HEADS, 2, PEER_DHALF)
    s = jnp.einsum('thcd,hcnd->thcn', q, sub_keys).astype(jnp.float32)
    s1v, s1i = lax.top_k(s[:, :, 0], PEER_TOPK)
    s2v, s2i = lax.top_k(s[:, :, 1], PEER_TOPK)
    cand = (s1v[..., :, None] + s2v[..., None, :]).reshape(T, PEER_HEADS, PEER_TOPK * PEER_TOPK)
    cidx = (s1i[..., :, None] * PEER_NKEYS + s2i[..., None, :]).reshape(T, PEER_HEADS, PEER_TOPK * PEER_TOPK)
    top_s, top_pos = lax.top_k(cand, PEER_TOPK)
    eidx = jnp.take_along_axis(cidx, top_pos, axis=-1)
    gates = jax.nn.softmax(top_s, axis=-1)
    nblk = T // PEER_TOKEN_BLOCK
    xb = xt.reshape(nblk, PEER_TOKEN_BLOCK, D)
    eb = eidx.reshape(nblk, PEER_TOKEN_BLOCK, PEER_HEADS * PEER_TOPK)
    gb = gates.reshape(nblk, PEER_TOKEN_BLOCK, PEER_HEADS * PEER_TOPK)

    def block(args):
        xs, es, gs = args
        a = jnp.einsum('td,ted->te', xs, u[es])
        hact = (jax.nn.gelu(a.astype(jnp.float32)) * gs).astype(xs.dtype)
        return jnp.einsum('te,ted->td', hact, v[es])

    out = lax.map(block, (xb, eb, gb))
    return out.reshape(B, S, D)


def setup_inputs(seed: int = 0) -> dict:
    key = jax.random.key(seed)
    ks = jax.random.split(key, 16)
    f32 = jnp.float32

    def nrm(k, shape, scale):
        return jax.random.normal(k, shape, f32) * scale

    return {
        "x": nrm(ks[0], (BATCH, SEQ, D_MODEL), 1.0),
        "meta_tokens": nrm(ks[1], (N_META, D_MODEL), 1.0),
        "hgrn_lb_logits": nrm(ks[2], (DEPTH + 1, HK), 0.5),
        "ln_mix_g": 1.0 + nrm(ks[3], (DEPTH, D_MODEL), 0.02),
        "w_in": nrm(ks[4], (DEPTH, D_MODEL, IN_COLS), D_MODEL ** -0.5),
        "q_norm_g": 1.0 + nrm(ks[5], (DEPTH, HEAD_DIM), 0.02),
        "k_norm_g": 1.0 + nrm(ks[6], (DEPTH, HEAD_DIM), 0.02),
        "attn_sinks": nrm(ks[7], (DEPTH, ATT_Q_HEADS), 0.5),
        "hgrn_norm_g": 1.0 + nrm(ks[8], (DEPTH, HV), 0.02),
        "w_out": nrm(ks[9], (DEPTH, MIX_WIDTH, D_MODEL), MIX_WIDTH ** -0.5),
        "ln_ffn_g": 1.0 + nrm(ks[10], (DEPTH, D_MODEL), 0.02),
        "peer_w_q": nrm(ks[11], (DEPTH, D_MODEL, PEER_HEADS * PEER_DKEY), D_MODEL ** -0.5),
        "peer_sub_keys": nrm(ks[12], (DEPTH, PEER_HEADS, 2, PEER_NKEYS, PEER_DHALF), PEER_DHALF ** -0.5),
        "peer_u": nrm(ks[13], (DEPTH, PEER_N, D_MODEL), D_MODEL ** -0.5),
        "peer_v": nrm(ks[14], (DEPTH, PEER_N, D_MODEL), 0.25),
    }


def reference(x, meta_tokens, hgrn_lb_logits, ln_mix_g, w_in, q_norm_g, k_norm_g, attn_sinks,
              hgrn_norm_g, w_out, ln_ffn_g, peer_w_q, peer_sub_keys, peer_u, peer_v):
    B, S, D = x.shape
    meta = jnp.broadcast_to(meta_tokens[None].astype(x.dtype), (B, N_META, D))
    h = jnp.concatenate([meta, x], axis=1)
    L = S + N_META
    pos = jnp.arange(L)
    lbs = jnp.cumsum(jax.nn.softmax(hgrn_lb_logits.astype(jnp.float32), axis=0), axis=0)
    split_at = list(np.cumsum(IN_SPLITS)[:-1])
    for l in range(DEPTH):
        hn = rms_norm(h, ln_mix_g[l])
        proj = hn @ w_in[l]
        aq, ak, av, hq, hf, hi, hg = jnp.split(proj, split_at, axis=-1)
        aq = partial_rope(rms_norm(aq.reshape(B, L, ATT_Q_HEADS, HEAD_DIM), q_norm_g[l]), pos)
        ak = partial_rope(rms_norm(ak.reshape(B, L, ATT_KV_HEADS, HEAD_DIM), k_norm_g[l]), pos)
        av = av.reshape(B, L, ATT_KV_HEADS, HEAD_DIM)
        att = sliding_window_sink_attention(aq, ak, av, attn_sinks[l])
        rec = hgrn2_mixer(hq, hf, hi, hg, lbs[l], hgrn_norm_g[l])
        h = h + jnp.concatenate([att, rec], axis=-1) @ w_out[l]
        if l == DEPTH - 1:
            h = h[:, N_META:]
        h = h + peer_ffn(rms_norm(h, ln_ffn_g[l]), peer_w_q[l], peer_sub_keys[l], peer_u[l], peer_v[l])
    return h
```

```cpp
#include <hip/hip_runtime.h>
#include <hip/hip_cooperative_groups.h>
#include <cstdio>
namespace cg = cooperative_groups;

#ifndef REP
#define REP 0
#endif
#ifndef MK_SINGLE
#define MK_SINGLE 1
#endif

#define LAS __attribute__((address_space(3)))
#define DI __device__ __forceinline__
typedef unsigned short bf16_t;
typedef short bf16x8 __attribute__((ext_vector_type(8)));
typedef short s16x4 __attribute__((ext_vector_type(4)));
typedef float f32x4 __attribute__((ext_vector_type(4)));
typedef float f32x16 __attribute__((ext_vector_type(16)));
typedef unsigned u32x4 __attribute__((ext_vector_type(4)));
typedef unsigned u32x2 __attribute__((ext_vector_type(2)));
typedef __bf16 bf16x2_t __attribute__((ext_vector_type(2)));
typedef float f32x2 __attribute__((ext_vector_type(2)));

constexpr int D = 2048, SEQ = 2048, T = 16384, NMETA = 16, MROWS = 16640, INC = 5632;
constexpr int COL_K = 1024, COL_V = 1280, COL_HQ = 1536, COL_HF = 2560, COL_HI = 3584, COL_HG = 4608;
constexpr float RMS_EPS = 1e-6f;
constexpr float LOG2E = 1.4426950408889634f;

constexpr size_t OFF_WINT = 0;
constexpr size_t OFF_WOUTT = OFF_WINT + (size_t)INC * D * 2;
constexpr size_t OFF_WQT = OFF_WOUTT + (size_t)D * D * 2;
constexpr size_t OFF_HN = OFF_WQT + (size_t)D * D * 2;
constexpr size_t OFF_PROJ = OFF_HN + (size_t)MROWS * D * 2;
constexpr size_t OFF_MIX = OFF_PROJ + (size_t)MROWS * INC * 2;
constexpr size_t OFF_UB = OFF_MIX + (size_t)T * D * 2;
constexpr size_t OFF_VB = OFF_UB + (size_t)16384 * D * 2;
constexpr size_t OFF_SK = OFF_VB + (size_t)16384 * D * 2;
constexpr size_t OFF_ROPE = OFF_SK + (size_t)262144 * 2;
constexpr size_t OFF_LB = OFF_ROPE + (size_t)2064 * 32 * 4;
constexpr size_t OFF_SU = OFF_LB + 4096;
constexpr size_t OFF_SV = OFF_SU + 65536;
constexpr size_t OFF_XBAR = OFF_SV + 65536;
constexpr size_t OFF_HE = OFF_XBAR + 16384;
constexpr size_t OFF_EI = OFF_HE + (size_t)T * 128 * 4;
constexpr size_t WS_NEED = OFF_EI + (size_t)T * 128 * 4;
constexpr int DYN_LDS = 155648;

struct Params {
    const float *x, *meta, *lb_logits, *ln_mix_g, *w_in, *q_norm_g, *k_norm_g, *sinks, *hgrn_norm_g, *w_out, *ln_ffn_g, *peer_wq, *sub_keys, *peer_u, *peer_v;
    float* out;
    unsigned char* ws;
};

DI unsigned pk2(float a, float b) { f32x2 v = {a, b}; bf16x2_t r = __builtin_convertvector(v, bf16x2_t); return __builtin_bit_cast(unsigned, r); }
DI bf16_t f2bf(float a) { return (bf16_t)(pk2(a, 0.f) & 0xffffu); }
DI float bf_lo(unsigned u) { return __uint_as_float(u << 16); }
DI float bf_hi(unsigned u) { return __uint_as_float(u & 0xffff0000u); }
DI float bf2f(bf16_t h) { return __uint_as_float(((unsigned)h) << 16); }
DI float shx(float v, int m) { return __shfl_xor(v, m, 64); }
DI int shxi(int v, int m) { return __shfl_xor(v, m, 64); }
DI float fast_exp(float x) { return __builtin_amdgcn_exp2f(x * LOG2E); }
DI float fast_rcp(float x) { return __builtin_amdgcn_rcpf(x); }
DI float dot2u(unsigned w, unsigned x, float acc) { return __builtin_amdgcn_fdot2_f32_bf16(__builtin_bit_cast(bf16x2_t, w), __builtin_bit_cast(bf16x2_t, x), acc, false); }
DI f32x16 mfma32(bf16x8 a, bf16x8 b, f32x16 c) { return __builtin_amdgcn_mfma_f32_32x32x16_bf16(a, b, c, 0, 0, 0); }
DI f32x4 mfma16(bf16x8 a, bf16x8 b, f32x4 c) { return __builtin_amdgcn_mfma_f32_16x16x32_bf16(a, b, c, 0, 0, 0); }
DI bf16x8 pack8(const float* f) { u32x4 w; w.x = pk2(f[0], f[1]); w.y = pk2(f[2], f[3]); w.z = pk2(f[4], f[5]); w.w = pk2(f[6], f[7]); return __builtin_bit_cast(bf16x8, w); }
DI void unpack8(u32x4 w, float* f) { f[0] = bf_lo(w.x); f[1] = bf_hi(w.x); f[2] = bf_lo(w.y); f[3] = bf_hi(w.y); f[4] = bf_lo(w.z); f[5] = bf_hi(w.z); f[6] = bf_lo(w.w); f[7] = bf_hi(w.w); }

namespace pg8 {
constexpr int BM = 256, BK = 64, HALF = 128, HTB = HALF * BK * 2, STAGE_BYTES = 8 * HTB, NXCD = 8, WGM = 8;
DI int lds_byte(int r, int c) { const int st = (r >> 4) * 2 + (c >> 5), rr = r & 15, cc = c & 31, ob = rr * 64 + cc * 2; return st * 1024 + (ob ^ (((ob >> 9) & 1) << 5)); }
DI void stage_rc(int b, int& R, int& C) { const int st = b / 1024, sb = b % 1024, swz = sb ^ (((sb >> 9) & 1) << 5); R = (st >> 1) * 16 + swz / 64; C = (st & 1) * 32 + (swz % 64) / 2; }
DI int perm32(int rho) { const int n = rho >> 4, i = rho & 15; return 8 * (i >> 2) + 4 * n + (i & 3); }
struct Unit { int pm, pn; };
struct Gemm { const bf16_t* A; const bf16_t* Bt; int M, N, K; };
struct StaticOrder {
    int nM, nN, nwg, G, c;
    DI void init(int M, int N, int G_, int c_) { nM = M / BM; nN = N / BM; nwg = nM * nN; G = G_; c = c_; }
    DI bool next(int i, Unit& u) const {
        const long L = (long)i * G + c; if (L >= nwg) return false;
        int wgid = (int)L; { const int q = nwg / NXCD, r = nwg % NXCD, xcd = wgid % NXCD, off = wgid / NXCD; wgid = (xcd < r ? xcd * (q + 1) : r * (q + 1) + (xcd - r) * q) + off; }
        const int nig = WGM * nN, gid = wgid / nig, fm = gid * WGM, gsz = (nM - fm) < WGM ? (nM - fm) : WGM;
        u.pm = fm + ((wgid % nig) % gsz); u.pn = (wgid % nig) / gsz; return true;
    }
};
struct EpiBf16 {
    static constexpr bool PERM = true;
    bf16_t* O; int ldc; int acts;
    DI void operator()(const f32x4 (&acc)[2][2][4][2], const Unit& u, int wr, int wc, int fr, int fq) const {
        const int row0 = u.pm * BM + wr * 64 + fr; const int col0 = u.pn * BM + wc * 32 + 8 * fq;
        const int kind = !acts ? 0 : (((u.pn >= 6 && u.pn < 10) || u.pn >= 18) ? 1 : ((u.pn >= 10 && u.pn < 14) ? 2 : 0));
#pragma unroll
        for (int ai = 0; ai < 2; ++ai)
#pragma unroll
            for (int m = 0; m < 4; ++m) { bf16_t* rowp = O + (size_t)(row0 + ai * HALF + m * 16) * ldc + col0;
#pragma unroll
                for (int bj = 0; bj < 2; ++bj) { f32x4 v0 = acc[ai][bj][m][0], v1 = acc[ai][bj][m][1];
                    if (kind == 1) {
#pragma unroll
                        for (int j = 0; j < 4; ++j) { v0[j] = v0[j] * fast_rcp(1.f + fast_exp(-v0[j])); v1[j] = v1[j] * fast_rcp(1.f + fast_exp(-v1[j])); } }
                    else if (kind == 2) {
#pragma unroll
                        for (int j = 0; j < 4; ++j) { v0[j] = fast_rcp(1.f + fast_exp(v0[j])); v1[j] = fast_rcp(1.f + fast_exp(v1[j])); } }
                    u32x4 w; w.x = pk2(v0[0], v0[1]); w.y = pk2(v0[2], v0[3]); w.z = pk2(v1[0], v1[1]); w.w = pk2(v1[2], v1[3]);
                    *(u32x4*)(rowp + bj * HALF) = w; } }
    }
};
struct EpiBf16Res {
    static constexpr bool PERM = true;
    bf16_t* O; const float* R; int ldc;
    DI void operator()(const f32x4 (&acc)[2][2][4][2], const Unit& u, int wr, int wc, int fr, int fq) const {
        const int row0 = u.pm * BM + wr * 64 + fr; const int col0 = u.pn * BM + wc * 32 + 8 * fq;
#pragma unroll
        for (int ai = 0; ai < 2; ++ai)
#pragma unroll
            for (int m = 0; m < 4; ++m) { const size_t ro = (size_t)(row0 + ai * HALF + m * 16) * ldc + col0;
#pragma unroll
                for (int bj = 0; bj < 2; ++bj) { const f32x4 r0 = *(const f32x4*)(R + ro + bj * HALF), r1 = *(const f32x4*)(R + ro + bj * HALF + 4);
                    const f32x4 v0 = acc[ai][bj][m][0] + r0, v1 = acc[ai][bj][m][1] + r1;
                    u32x4 w; w.x = pk2(v0[0], v0[1]); w.y = pk2(v0[2], v0[3]); w.z = pk2(v1[0], v1[1]); w.w = pk2(v1[2], v1[3]);
                    *(u32x4*)(O + ro + bj * HALF) = w; } }
    }
};
struct EpiF32Res {
    static constexpr bool PERM = false;
    float* C; const float* R; int ldc; bf16_t* Hb;
    DI void operator()(const f32x4 (&acc)[2][2][4][2], const Unit& u, int wr, int wc, int fr, int fq) const {
        const int row0 = u.pm * BM + wr * 64 + fr, col0 = u.pn * BM + wc * 32 + 4 * fq;
#pragma unroll
        for (int ai = 0; ai < 2; ++ai)
#pragma unroll
            for (int m = 0; m < 4; ++m) { const size_t ro = (size_t)(row0 + ai * HALF + m * 16) * ldc + col0;
#pragma unroll
                for (int bj = 0; bj < 2; ++bj)
#pragma unroll
                    for (int n = 0; n < 2; ++n) { const f32x4 rv = *(const f32x4*)(R + ro + bj * HALF + n * 16); const f32x4 hv = acc[ai][bj][m][n] + rv; if (C) *(f32x4*)(C + ro + bj * HALF + n * 16) = hv;
                        u32x2 hb; hb.x = pk2(hv[0], hv[1]); hb.y = pk2(hv[2], hv[3]); *(u32x2*)(Hb + ro + bj * HALF + n * 16) = hb; } }
    }
};

template <class Epi, class Sched>
DI void gemm_phase(LAS unsigned char* lds, const Gemm g, const Sched& S, const Epi& E) {
    const int tid = threadIdx.x, wid = __builtin_amdgcn_readfirstlane(tid >> 6), lane = tid & 63, wr = wid >> 2, wc = wid & 3, fr = lane & 15, fq = lane >> 4;
    const int K = g.K, nt = K / BK;
    unsigned voffA[2], voffB[2];
#pragma unroll
    for (int i = 0; i < 2; ++i) { int R, C; stage_rc(tid * 16 + i * 8192, R, C); const int Rb = Epi::PERM ? ((R & ~31) + perm32(R & 31)) : R;
        voffA[i] = (unsigned)(R * K + C) * 2u; voffB[i] = (unsigned)(Rb * K + C) * 2u; }
    const size_t kstep = (size_t)(BK * 2);
    const size_t hstep = (size_t)HALF * K * 2;
    const size_t tstep = 2 * hstep;
    const unsigned ldsw = (unsigned)wid * 1024u;
    const int aoff = lds_byte(wr * 64 + fr, fq * 8), boff = lds_byte(wc * 32 + fr, fq * 8);
#define PG8_SA(b, h) (((b) * 2 + (h)) * HTB)
#define PG8_SB(b, h) ((4 + (b) * 2 + (h)) * HTB)
#define PG8_STAGE(bufoff, gbase, voff) do { _Pragma("unroll") for (int _i = 0; _i < 2; ++_i) \
        __builtin_amdgcn_global_load_lds((const unsigned*)((const char*)(gbase) + (voff)[_i]), (LAS unsigned*)(lds + (bufoff) + ldsw + _i * 8192), 16, 0, 0); } while (0)
#define PG8_LDA(dst, b, h) do { _Pragma("unroll") for (int m = 0; m < 4; ++m) _Pragma("unroll") for (int k = 0; k < 2; ++k) dst[m][k] = *(const LAS bf16x8*)(lds + PG8_SA(b, h) + aoff + m * 2048 + k * 1024); } while (0)
#define PG8_LDB(dst, b, h) do { _Pragma("unroll") for (int n = 0; n < 2; ++n) _Pragma("unroll") for (int k = 0; k < 2; ++k) dst[n][k] = *(const LAS bf16x8*)(lds + PG8_SB(b, h) + boff + n * 2048 + k * 1024); } while (0)
#define PG8_MMA(ai, bj, At, Bt) do { __builtin_amdgcn_s_setprio(1); _Pragma("unroll") for (int m = 0; m < 4; ++m) _Pragma("unroll") for (int n = 0; n < 2; ++n) _Pragma("unroll") for (int k = 0; k < 2; ++k) \
        acc[ai][bj][m][n] = __builtin_amdgcn_mfma_f32_16x16x32_bf16(Bt[n][k], At[m][k], acc[ai][bj][m][n], 0, 0, 0); __builtin_amdgcn_s_setprio(0); } while (0)
#define PG8_WAIT_V(n) asm volatile("s_waitcnt vmcnt(" #n ")" ::: "memory")
#define PG8_WAIT_L(n) asm volatile("s_waitcnt lgkmcnt(" #n ")" ::: "memory")
#define PG8_BAR __builtin_amdgcn_s_barrier()
#define PG8_SCHED __builtin_amdgcn_sched_barrier(0)
    Unit cur, nxt; int ui = 0;
    if (!S.next(0, cur)) return;
    f32x4 acc[2][2][4][2];
#pragma unroll
    for (int a = 0; a < 2; ++a)
#pragma unroll
        for (int b = 0; b < 2; ++b)
#pragma unroll
            for (int m = 0; m < 4; ++m)
#pragma unroll
                for (int n = 0; n < 2; ++n) acc[a][b][m][n] = (f32x4){0.f, 0.f, 0.f, 0.f};
    bf16x8 At[4][2], B0[2][2], B1[2][2];
    const char* cA = (const char*)g.A + (size_t)cur.pm * tstep; const char* cB = (const char*)g.Bt + (size_t)cur.pn * tstep;
    PG8_STAGE(PG8_SB(0, 0), cB, voffB); PG8_STAGE(PG8_SA(0, 0), cA, voffA); PG8_STAGE(PG8_SB(0, 1), cB + hstep, voffB); PG8_STAGE(PG8_SA(0, 1), cA + hstep, voffA);
    if (wr == 1) PG8_BAR;
    PG8_WAIT_V(4); PG8_BAR;
    PG8_STAGE(PG8_SB(1, 0), cB + kstep, voffB); PG8_STAGE(PG8_SA(1, 0), cA + kstep, voffA); PG8_STAGE(PG8_SB(1, 1), cB + hstep + kstep, voffB);
    PG8_WAIT_V(6); PG8_BAR;
    for (;;) {
        const bool has_next = S.next(ui + 1, nxt);
        const char* nA = has_next ? (const char*)g.A + (size_t)nxt.pm * tstep : cA; const char* nB = has_next ? (const char*)g.Bt + (size_t)nxt.pn * tstep : cB;
        for (int t = 0; t < nt; t += 2) {
            const bool last = (t == nt - 2);
            const char* a1 = cA + (size_t)(t + 1) * kstep;
            const char* a2 = last ? nA : cA + (size_t)(t + 2) * kstep; const char* b2 = last ? nB : cB + (size_t)(t + 2) * kstep;
            const char* a3 = a2 + kstep; const char* b3 = b2 + kstep;
            PG8_LDB(B0, 0, 0); PG8_SCHED; PG8_LDA(At, 0, 0); PG8_STAGE(PG8_SA(1, 1), a1 + hstep, voffA);
            PG8_WAIT_L(8); PG8_BAR; PG8_WAIT_L(0); PG8_MMA(0, 0, At, B0); PG8_BAR; PG8_SCHED;
            PG8_LDB(B1, 0, 1); PG8_STAGE(PG8_SB(0, 0), b2, voffB);
            PG8_BAR; PG8_WAIT_L(0); PG8_MMA(0, 1, At, B1); PG8_BAR;
            PG8_LDA(At, 0, 1); PG8_STAGE(PG8_SA(0, 0), a2, voffA);
            PG8_BAR; PG8_WAIT_L(0); PG8_MMA(1, 0, At, B0); PG8_BAR; PG8_SCHED;
            PG8_STAGE(PG8_SB(0, 1), b2 + hstep, voffB);
            PG8_WAIT_V(6); PG8_BAR; PG8_MMA(1, 1, At, B1); PG8_BAR;
            PG8_LDB(B0, 1, 0); PG8_SCHED; PG8_LDA(At, 1, 0); PG8_STAGE(PG8_SA(0, 1), a2 + hstep, voffA);
            PG8_WAIT_L(8); PG8_BAR; PG8_WAIT_L(0); PG8_MMA(0, 0, At, B0); PG8_BAR; PG8_SCHED;
            PG8_LDB(B1, 1, 1); PG8_STAGE(PG8_SB(1, 0), b3, voffB);
            PG8_BAR; PG8_WAIT_L(0); PG8_MMA(0, 1, At, B1); PG8_BAR;
            PG8_LDA(At, 1, 1); PG8_STAGE(PG8_SA(1, 0), a3, voffA);
            PG8_BAR; PG8_WAIT_L(0); PG8_MMA(1, 0, At, B0); PG8_BAR; PG8_SCHED;
            PG8_STAGE(PG8_SB(1, 1), b3 + hstep, voffB);
            PG8_WAIT_V(6); PG8_BAR; PG8_MMA(1, 1, At, B1); PG8_BAR;
        }
        E(acc, cur, wr, wc, fr, fq);
        if (!has_next) break;
#pragma unroll
        for (int a = 0; a < 2; ++a)
#pragma unroll
            for (int b = 0; b < 2; ++b)
#pragma unroll
                for (int m = 0; m < 4; ++m)
#pragma unroll
                    for (int n = 0; n < 2; ++n) acc[a][b][m][n] = (f32x4){0.f, 0.f, 0.f, 0.f};
        cur = nxt; cA = nA; cB = nB; ++ui;
    }
    PG8_WAIT_V(0);
    if (wr == 0) PG8_BAR;
    PG8_BAR;
#undef PG8_SA
#undef PG8_SB
#undef PG8_STAGE
#undef PG8_LDA
#undef PG8_LDB
#undef PG8_MMA
#undef PG8_WAIT_V
#undef PG8_WAIT_L
#undef PG8_BAR
#undef PG8_SCHED
}
}

DI void rms_row(const float* src, const float* g, bf16_t* dst, int lane) {
    f32x4 v[8]; float ss = 0.f;
#pragma unroll
    for (int i = 0; i < 4; ++i) { v[2 * i] = *(const f32x4*)(src + 512 * i + 8 * lane); v[2 * i + 1] = *(const f32x4*)(src + 512 * i + 8 * lane + 4); }
#pragma unroll
    for (int i = 0; i < 8; ++i) ss += v[i][0] * v[i][0] + v[i][1] * v[i][1] + v[i][2] * v[i][2] + v[i][3] * v[i][3];
#pragma unroll
    for (int m = 1; m < 64; m <<= 1) ss += shx(ss, m);
    const float rs = __builtin_amdgcn_rsqf(ss * (1.f / 2048.f) + RMS_EPS);
#pragma unroll
    for (int i = 0; i < 4; ++i) {
        const f32x4 g0 = *(const f32x4*)(g + 512 * i + 8 * lane), g1 = *(const f32x4*)(g + 512 * i + 8 * lane + 4);
        const f32x4 a = v[2 * i] * rs * g0, b = v[2 * i + 1] * rs * g1;
        u32x4 w; w.x = pk2(a[0], a[1]); w.y = pk2(a[2], a[3]); w.z = pk2(b[0], b[1]); w.w = pk2(b[2], b[3]);
        *(u32x4*)(dst + 512 * i + 8 * lane) = w;
    }
}

DI void phase0(const Params& p, unsigned char* lds, int bid, int nb, const int part) {
    const int tid = threadIdx.x, lane = tid & 63, wid = tid >> 6;
    float* tile = (float*)lds;
    constexpr int U_IN = 32 * 22, U_SQ = 32 * 8;
    for (int u = bid + (part ? U_IN : 0); u < (part ? U_IN + 2 * U_SQ : U_IN); u += nb) {
        const float* W; bf16_t* Wt; int N; int uu = u;
        if (uu < U_IN) { W = p.w_in; Wt = (bf16_t*)(p.ws + OFF_WINT); N = INC; }
        else if (uu < U_IN + U_SQ) { uu -= U_IN; W = p.w_out; Wt = (bf16_t*)(p.ws + OFF_WOUTT); N = D; }
        else { uu -= U_IN + U_SQ; W = p.peer_wq; Wt = (bf16_t*)(p.ws + OFF_WQT); N = D; }
        const bool foldg = (u >= U_IN + U_SQ);
        const int ntl = N / 256; const int k0 = (uu / ntl) * 64, n0 = (uu % ntl) * 256;
        f32x4 tv[8];
#pragma unroll
        for (int i = 0; i < 8; ++i) tv[i] = *(const f32x4*)(W + (size_t)(k0 + (tid >> 6) + 8 * i) * N + n0 + 4 * (tid & 63));
#pragma unroll
        for (int i = 0; i < 8; ++i) *(f32x4*)(tile + ((tid >> 6) + 8 * i) * 260 + 4 * (tid & 63)) = tv[i];
        __syncthreads();
#pragma unroll
        for (int i = 0; i < 4; ++i) { const int task = tid + 512 * i, n = task >> 3, kc = task & 7; float f[8];
#pragma unroll
            for (int j = 0; j < 8; ++j) { f[j] = tile[(kc * 8 + j) * 260 + n]; if (foldg) f[j] *= p.ln_ffn_g[k0 + kc * 8 + j]; }
            *(bf16x8*)(Wt + (size_t)(n0 + n) * 2048 + k0 + kc * 8) = pack8(f); }
        __syncthreads();
    }
    bf16_t* HN = (bf16_t*)(p.ws + OFF_HN);
    if (part == 0)
    for (int u = bid; u < MROWS / 16; u += nb) {
        const int r0 = (u * 8 + wid) * 2;
        if (r0 >= T + NMETA) { const u32x4 z = {0u, 0u, 0u, 0u};
#pragma unroll
            for (int rr = 0; rr < 2; ++rr)
#pragma unroll
                for (int i = 0; i < 4; ++i) *(u32x4*)(HN + (size_t)(r0 + rr) * D + 512 * i + 8 * lane) = z; }
        else {
            const float* s0 = r0 < T ? p.x + (size_t)r0 * D : p.meta + (size_t)(r0 - T) * D; const float* s1 = s0 + D;
            f32x4 va[8], vb[8];
#pragma unroll
            for (int i = 0; i < 8; ++i) { va[i] = *(const f32x4*)(s0 + 256 * i + 4 * lane); vb[i] = *(const f32x4*)(s1 + 256 * i + 4 * lane); }
            float sa = 0.f, sb = 0.f;
#pragma unroll
            for (int i = 0; i < 8; ++i) { sa += va[i][0] * va[i][0] + va[i][1] * va[i][1] + va[i][2] * va[i][2] + va[i][3] * va[i][3]; sb += vb[i][0] * vb[i][0] + vb[i][1] * vb[i][1] + vb[i][2] * vb[i][2] + vb[i][3] * vb[i][3]; }
#pragma unroll
            for (int m = 1; m < 64; m <<= 1) { sa += shx(sa, m); sb += shx(sb, m); }
            const float ra = __builtin_amdgcn_rsqf(sa * (1.f / 2048.f) + RMS_EPS), rb = __builtin_amdgcn_rsqf(sb * (1.f / 2048.f) + RMS_EPS);
#pragma unroll
            for (int i = 0; i < 8; ++i) {
                const f32x4 g0 = *(const f32x4*)(p.ln_mix_g + 256 * i + 4 * lane);
                { const f32x4 a = va[i] * ra * g0; u32x2 w; w.x = pk2(a[0], a[1]); w.y = pk2(a[2], a[3]); *(u32x2*)(HN + (size_t)r0 * D + 256 * i + 4 * lane) = w; }
                { const f32x4 a = vb[i] * rb * g0; u32x2 w; w.x = pk2(a[0], a[1]); w.y = pk2(a[2], a[3]); *(u32x2*)(HN + (size_t)(r0 + 1) * D + 256 * i + 4 * lane) = w; }
            }
        }
    }
    {
        unsigned char* UBq = p.ws + OFF_UB; unsigned char* VBq = p.ws + OFF_VB; float* SU = (float*)(p.ws + OFF_SU); float* SV = (float*)(p.ws + OFF_SV);
        auto quant_row = [&](f32x4 (&v)[8], const int which, const int e) {
            if (which == 0) {
                float ss = 0.f;
#pragma unroll
                for (int i = 0; i < 8; ++i) ss += v[i][0] * v[i][0] + v[i][1] * v[i][1] + v[i][2] * v[i][2] + v[i][3] * v[i][3];
#pragma unroll
                for (int m = 1; m < 64; m <<= 1) ss += shx(ss, m);
                const float step = 0.335f * __builtin_sqrtf(ss * (1.f / 2048.f)); const float inv = step > 0.f ? 1.f / step : 0.f;
                u32x4 w;
#pragma unroll
                for (int d = 0; d < 4; ++d) { const f32x4 t0 = v[2 * d] * inv + 8.f, t1 = v[2 * d + 1] * inv + 8.f; unsigned pw = 0u;
#pragma unroll
                    for (int j = 0; j < 4; ++j) { const int n0 = (int)fminf(fmaxf(floorf(t0[j]), 0.f), 15.f), n1 = (int)fminf(fmaxf(floorf(t1[j]), 0.f), 15.f); pw |= ((unsigned)n0 | ((unsigned)n1 << 4)) << (8 * j); }
                    w[d] = pw; }
                *(u32x4*)(UBq + (size_t)e * 1024 + 16 * lane) = w;
                if (lane == 0) SU[e] = step;
            } else {
                float am = 0.f;
#pragma unroll
                for (int i = 0; i < 8; ++i) am = fmaxf(fmaxf(fmaxf(am, fabsf(v[i][0])), fmaxf(fabsf(v[i][1]), fabsf(v[i][2]))), fabsf(v[i][3]));
#pragma unroll
                for (int m = 1; m < 64; m <<= 1) am = fmaxf(am, shx(am, m));
                const float sc = am > 0.f ? 6.f / am : 0.f, isc = am * (1.f / 6.f);
                u32x4 w;
#pragma unroll
                for (int d = 0; d < 4; ++d) { const f32x4 t0 = v[2 * d] * sc, t1 = v[2 * d + 1] * sc; unsigned pw = 0u;
                    pw = __builtin_amdgcn_cvt_scalef32_pk_fp4_f32(pw, t0[0], t0[1], 1.0f, 0); pw = __builtin_amdgcn_cvt_scalef32_pk_fp4_f32(pw, t0[2], t0[3], 1.0f, 1);
                    pw = __builtin_amdgcn_cvt_scalef32_pk_fp4_f32(pw, t1[0], t1[1], 1.0f, 2); pw = __builtin_amdgcn_cvt_scalef32_pk_fp4_f32(pw, t1[2], t1[3], 1.0f, 3); w[d] = pw; }
                *(u32x4*)(VBq + (size_t)e * 1024 + 16 * lane) = w;
                if (lane == 0) SV[e] = isc;
            }
        };
        if (part == 1)
        for (int u = bid; u < 2048; u += nb) {
            const int rowi = (u * 8 + wid) * 2; const int which = rowi >> 14, e = rowi & 16383;
            const float* src = (which ? p.peer_v : p.peer_u) + (size_t)e * D + 4 * lane;
            f32x4 va[8], vb[8];
#pragma unroll
            for (int i = 0; i < 8; ++i) { va[i] = *(const f32x4*)(src + 256 * i); vb[i] = *(const f32x4*)(src + D + 256 * i); }
            if (which == 0) {
#pragma unroll
                for (int i = 0; i < 8; ++i) { const f32x4 gg = *(const f32x4*)(p.ln_ffn_g + 4 * lane + 256 * i); va[i] = va[i] * gg; vb[i] = vb[i] * gg; } }
            quant_row(va, which, e); quant_row(vb, which, e + 1);
        }
    }
    if (part == 1)
    for (int u = bid; u < 64; u += nb) {
        const size_t idx = ((size_t)u * 512 + tid) * 8; const float* src = p.sub_keys + idx; bf16_t* dst = (bf16_t*)(p.ws + OFF_SK) + idx;
        const f32x4 a = *(const f32x4*)src, b = *(const f32x4*)(src + 4);
        u32x4 w; w.x = pk2(a[0], a[1]); w.y = pk2(a[2], a[3]); w.z = pk2(b[0], b[1]); w.w = pk2(b[2], b[3]);
        *(u32x4*)dst = w;
    }
    float* ROPE = (float*)(p.ws + OFF_ROPE);
    if (part == 0)
    for (int u = bid; u < 65; u += nb) {
        const int idx = u * 512 + tid;
        if (idx < 2064 * 16) { const int pos = idx >> 4, i = idx & 15;
            const float inv = exp2f(-(float)i * (18.931568569324174f / 16.f));
            const float ang = (float)pos * inv; const float rev = ang * 0.15915494309189535f; const float fr = rev - floorf(rev);
            ROPE[pos * 32 + i] = __builtin_amdgcn_cosf(fr); ROPE[pos * 32 + 16 + i] = __builtin_amdgcn_sinf(fr); }
    }
    float* LB = (float*)(p.ws + OFF_LB);
    if (part == 0)
    for (int u = bid; u < 2; u += nb) { const int k = u * 512 + tid; LB[k] = 1.f / (1.f + __expf(p.lb_logits[1024 + k] - p.lb_logits[k])); }
}

DI void phase_norm2(const Params& p, int bid, int nb) {
    const int lane = threadIdx.x & 63, wid = threadIdx.x >> 6;
    bf16_t* XN = (bf16_t*)(p.ws + OFF_HN);
    for (int u = bid; u < T / 8; u += nb) { const int r = u * 8 + wid; rms_row(p.out + (size_t)r * D, p.ln_ffn_g, XN + (size_t)r * D, lane); }
}

DI void attn_item(const Params& p, unsigned char* lds, int item) {
    const int kvh = item & 1, nbk = (item >> 1) & 15, b = item >> 5;
    const int tid = threadIdx.x, lane = tid & 63, wid = tid >> 6, h5 = lane >> 5, l31 = lane & 31;
    bf16_t* Ks = (bf16_t*)lds;
    bf16_t* Vt = (bf16_t*)(lds + 288 * 272);
    const bf16_t* proj = (const bf16_t*)(p.ws + OFF_PROJ);
    const float* ROPE = (const float*)(p.ws + OFF_ROPE);
    {
        const int sub = tid & 15, rp = tid >> 4;
        float kg[8];
#pragma unroll
        for (int j = 0; j < 8; ++j) kg[j] = p.k_norm_g[sub * 8 + j];
#pragma unroll 1
        for (int pg = 0; pg < 9; pg += 3) {
        u32x4 raws[3];
#pragma unroll
        for (int pass = pg; pass < pg + 3; ++pass) {
            const int slot = pass * 32 + rp; int row = -1;
            if (slot < 16) row = T + slot;
            else if (slot >= 32) { const int s = 128 * (nbk - 1) + (slot - 32); if (s >= 0) row = b * SEQ + s; }
            raws[pass - pg] = (u32x4){0u, 0u, 0u, 0u};
            if (row >= 0) raws[pass - pg] = *(const u32x4*)(proj + (size_t)row * INC + COL_K + kvh * 128 + sub * 8);
        }
#pragma unroll
        for (int pass = pg; pass < pg + 3; ++pass) {
            const int slot = pass * 32 + rp; int row = -1, pos = 0;
            if (slot < 16) { row = T + slot; pos = slot; }
            else if (slot >= 32) { const int s = 128 * (nbk - 1) + (slot - 32); if (s >= 0) { row = b * SEQ + s; pos = NMETA + s; } }
            const u32x4 raw = raws[pass - pg];
            float f[8]; unpack8(raw, f);
            float ss = 0.f;
#pragma unroll
            for (int j = 0; j < 8; ++j) ss += f[j] * f[j];
            ss += shx(ss, 1); ss += shx(ss, 2); ss += shx(ss, 4); ss += shx(ss, 8);
            const float rs = __builtin_amdgcn_rsqf(ss * (1.f / 128.f) + RMS_EPS);
            float pr[8];
#pragma unroll
            for (int j = 0; j < 8; ++j) { f[j] = f[j] * rs * kg[j]; pr[j] = shx(f[j], 2); }
            if (sub < 4 && row >= 0) { const float* cs = ROPE + pos * 32 + (sub & 1) * 8;
#pragma unroll
                for (int j = 0; j < 8; ++j) { const float c = cs[j], s = cs[16 + j]; f[j] = (sub < 2) ? (f[j] * c - pr[j] * s) : (f[j] * c + pr[j] * s); } }
            *(bf16x8*)(Ks + slot * 136 + sub * 8) = pack8(f);
        }
        }
    }
    {
#pragma unroll 1
        for (int ig = 0; ig < 9; ig += 3) {
        u32x4 raws[3];
#pragma unroll
        for (int it = ig; it < ig + 3; ++it) {
            const int idx = it * 512 + tid; const int key = idx % 288, dc = idx / 288; int row = -1;
            if (key < 16) row = T + key;
            else if (key >= 32) { const int s = 128 * (nbk - 1) + (key - 32); if (s >= 0) row = b * SEQ + s; }
            raws[it - ig] = (u32x4){0u, 0u, 0u, 0u};
            if (row >= 0) raws[it - ig] = *(const u32x4*)(proj + (size_t)row * INC + COL_V + kvh * 128 + dc * 8);
        }
#pragma unroll
        for (int it = ig; it < ig + 3; ++it) {
            const int idx = it * 512 + tid; const int key = idx % 288, dc = idx / 288;
            const u32x4 raw = raws[it - ig];
            bf16_t* vp = Vt + (dc * 8) * 292 + key;
            vp[0 * 292] = (bf16_t)(raw.x & 0xffffu); vp[1 * 292] = (bf16_t)(raw.x >> 16); vp[2 * 292] = (bf16_t)(raw.y & 0xffffu); vp[3 * 292] = (bf16_t)(raw.y >> 16);
            vp[4 * 292] = (bf16_t)(raw.z & 0xffffu); vp[5 * 292] = (bf16_t)(raw.z >> 16); vp[6 * 292] = (bf16_t)(raw.w & 0xffffu); vp[7 * 292] = (bf16_t)(raw.w >> 16);
        }
        }
    }
    __syncthreads();
    const int hq = kvh * 4 + (wid >> 1);
    const float sinkv = p.sinks[hq] * LOG2E;
    bf16_t* MIX = (bf16_t*)(p.ws + OFF_MIX);
#pragma unroll 1
    for (int qq = 0; qq < 2; ++qq) {
        const int qt = (wid & 1) * 2 + qq; const int iq = 32 * qt + l31; const int s = 128 * nbk + iq; const size_t row = (size_t)b * SEQ + s;
        bf16x8 qf[8];
        {
            u32x4 raw[8]; float ss = 0.f;
#pragma unroll
            for (int ks = 0; ks < 8; ++ks) { raw[ks] = *(const u32x4*)(proj + row * INC + hq * 128 + 16 * ks + 8 * h5); float f[8]; unpack8(raw[ks], f);
#pragma unroll
                for (int j = 0; j < 8; ++j) ss += f[j] * f[j]; }
            ss += shx(ss, 32);
            const float rs = __builtin_amdgcn_rsqf(ss * (1.f / 128.f) + RMS_EPS) * (0.08838834764831845f * LOG2E);
            {
                float f0[8], f1[8]; unpack8(raw[0], f0); unpack8(raw[1], f1);
                const float* cs = ROPE + (NMETA + s) * 32 + 8 * h5;
#pragma unroll
                for (int j = 0; j < 8; ++j) { const float c = cs[j], sn = cs[16 + j]; const float x1 = f0[j] * rs * p.q_norm_g[8 * h5 + j], x2 = f1[j] * rs * p.q_norm_g[16 + 8 * h5 + j];
                    f0[j] = x1 * c - x2 * sn; f1[j] = x2 * c + x1 * sn; }
                qf[0] = pack8(f0); qf[1] = pack8(f1);
            }
#pragma unroll
            for (int ks = 2; ks < 8; ++ks) { float f[8]; unpack8(raw[ks], f);
#pragma unroll
                for (int j = 0; j < 8; ++j) f[j] *= rs * p.q_norm_g[16 * ks + 8 * h5 + j];
                qf[ks] = pack8(f); }
        }
        float m = sinkv, l = 1.f;
        f32x16 O[4];
#pragma unroll
        for (int dt = 0; dt < 4; ++dt)
#pragma unroll
            for (int r = 0; r < 16; ++r) O[dt][r] = 0.f;
#pragma unroll 1
        for (int kt = -1; kt < 5; ++kt) {
            const int ktc = qt + kt; int slot0 = 0;
            if (kt >= 0) { if (nbk == 0 && ktc < 4) continue; slot0 = 32 + 32 * ktc; }
            f32x16 S;
#pragma unroll
            for (int r = 0; r < 16; ++r) S[r] = 0.f;
#pragma unroll
            for (int ks = 0; ks < 8; ++ks) { const bf16x8 kf = *(const bf16x8*)(Ks + (slot0 + l31) * 136 + 16 * ks + 8 * h5); S = mfma32(kf, qf[ks], S); }
            float tmax = -1e30f;
#pragma unroll
            for (int r = 0; r < 16; ++r) { const int kr = (r & 3) + 8 * (r >> 2) + 4 * h5; bool valid;
                if (kt < 0) valid = kr < 16; else { const int c = 32 * ktc + kr; valid = (c > iq) && (c <= 128 + iq) && (nbk > 0 || c >= 128); }
                S[r] = valid ? S[r] : -1e30f; tmax = fmaxf(tmax, S[r]); }
            tmax = fmaxf(tmax, shx(tmax, 32));
            const float mn = fmaxf(m, tmax); const float alpha = __builtin_amdgcn_exp2f(m - mn);
            float psum = 0.f;
#pragma unroll
            for (int r = 0; r < 16; ++r) { const float pv = __builtin_amdgcn_exp2f(S[r] - mn); psum += pv; S[r] = pv; }
            psum += shx(psum, 32);
            l = l * alpha + psum; m = mn;
#pragma unroll
            for (int dt = 0; dt < 4; ++dt)
#pragma unroll
                for (int r = 0; r < 16; ++r) O[dt][r] *= alpha;
#pragma unroll
            for (int sx = 0; sx < 2; ++sx) {
                float pf[8];
#pragma unroll
                for (int j = 0; j < 8; ++j) pf[j] = S[8 * sx + j];
                const bf16x8 pfr = pack8(pf);
#pragma unroll
                for (int dt = 0; dt < 4; ++dt) {
                    const bf16_t* vb = Vt + (32 * dt + l31) * 292 + slot0 + 16 * sx + 4 * h5;
                    const s16x4 lo = *(const s16x4*)vb, hi = *(const s16x4*)(vb + 8);
                    bf16x8 vf; vf[0] = lo[0]; vf[1] = lo[1]; vf[2] = lo[2]; vf[3] = lo[3]; vf[4] = hi[0]; vf[5] = hi[1]; vf[6] = hi[2]; vf[7] = hi[3];
                    O[dt] = mfma32(vf, pfr, O[dt]);
                }
            }
        }
        const float inv_l = 1.f / l;
        bf16_t* orow = MIX + row * D + hq * 128;
#pragma unroll
        for (int dt = 0; dt < 4; ++dt)
#pragma unroll
            for (int g4 = 0; g4 < 4; ++g4) { u32x2 w; w.x = pk2(O[dt][4 * g4] * inv_l, O[dt][4 * g4 + 1] * inv_l); w.y = pk2(O[dt][4 * g4 + 2] * inv_l, O[dt][4 * g4 + 3] * inv_l);
                *(u32x2*)(orow + 32 * dt + 8 * g4 + 4 * h5) = w; }
    }
    __syncthreads();
}

DI void lds_barrier() { asm volatile("s_waitcnt lgkmcnt(0)" ::: "memory"); __builtin_amdgcn_s_barrier(); asm volatile("" ::: "memory"); }
DI void hgrn_item(const Params& p, unsigned char* lds, int item) {
    const int h = item & 7, b = item >> 3;
    const int tid = threadIdx.x, lane = tid & 63, wid = tid >> 6, g = lane >> 4, l15 = lane & 15;
    bf16_t* QT = (bf16_t*)lds;
    bf16_t* KT = QT + 64 * 136;
    bf16_t* QB = KT + 64 * 136;
    bf16_t* KDT = QB + 64 * 136;
    bf16_t* VT = KDT + 128 * 72;
    bf16_t* SC = VT + 128 * 72;
    float* OL = (float*)(SC + 64 * 72);
    float* GT = OL + 64 * 132;
    float* BL = GT + 1024;
    const bf16_t* proj = (const bf16_t*)(p.ws + OFF_PROJ);
    bf16_t* MIX = (bf16_t*)(p.ws + OFF_MIX);
    const int kp = tid & 63, tg = tid >> 6;
    const float c1a = 1.f - ((const float*)(p.ws + OFF_LB))[h * 128 + 2 * kp], c1b = 1.f - ((const float*)(p.ws + OFF_LB))[h * 128 + 2 * kp + 1];
    const int vs = tid & 63, vc = tid >> 6;
    const int et = tid >> 3, eseg = tid & 7;
    float* GNL = BL + 128;
    if (tid < 128) GNL[tid] = p.hgrn_norm_g[h * 128 + tid];
    f32x4 S[8];
#pragma unroll
    for (int mt = 0; mt < 8; ++mt) S[mt] = (f32x4){0.f, 0.f, 0.f, 0.f};
    unsigned nq[8], nf[8]; u32x4 nva, nvb, nga, ngb;
    auto prefetch = [&](int c) {
#pragma unroll
        for (int i = 0; i < 8; ++i) { const int t = 8 * tg + i; int row;
            if (c == 0) row = T + max(t - 48, 0); else row = b * SEQ + 64 * (c - 1) + t;
            const bf16_t* pr = proj + (size_t)row * INC + h * 128 + 2 * kp; nf[i] = *(const unsigned*)(pr + COL_HF); nq[i] = *(const unsigned*)(pr + COL_HQ); }
        { int row; if (c == 0) row = T + max(vs - 48, 0); else row = b * SEQ + 64 * (c - 1) + vs;
          const bf16_t* pr = proj + (size_t)row * INC + COL_HI + h * 128 + 16 * vc; nva = *(const u32x4*)pr; nvb = *(const u32x4*)(pr + 8); }
        { const int cc = c > 0 ? c - 1 : 0; const bf16_t* gp = proj + ((size_t)b * SEQ + 64 * cc + et) * INC + COL_HG + h * 128 + 16 * eseg; nga = *(const u32x4*)gp; ngb = *(const u32x4*)(gp + 8); }
    };
    prefetch(0);
    for (int c = 0; c < 33; ++c) {
        unsigned cq[8], cf[8];
#pragma unroll
        for (int i = 0; i < 8; ++i) { cq[i] = nq[i]; cf[i] = nf[i]; }
        const bool vvalid = !(c == 0 && vs < 48); const u32x4 z4 = {0u, 0u, 0u, 0u};
        const u32x4 cva = vvalid ? nva : z4, cvb = vvalid ? nvb : z4, cga = nga, cgb = ngb;
        const bool padchunk = (c == 0);
        if (c < 32) prefetch(c + 1);
        {
            float bl[8][2], qs[8][2], kk[8][2]; float csa = 1.f, csb = 1.f;
#pragma unroll
            for (int i = 0; i < 8; ++i) {
                const int t = 8 * tg + i; const bool valid = !(padchunk && t < 48);
                const float ka = valid ? c1a * bf_lo(cf[i]) : 0.f, kb = valid ? c1b * bf_hi(cf[i]) : 0.f;
                csa *= (1.f - ka); csb *= (1.f - kb); bl[i][0] = csa; bl[i][1] = csb;
                qs[i][0] = valid ? bf_lo(cq[i]) : 0.f; qs[i][1] = valid ? bf_hi(cq[i]) : 0.f; kk[i][0] = ka; kk[i][1] = kb;
            }
            *(f32x2*)(GT + tg * 128 + 2 * kp) = (f32x2){csa, csb};
            {
                bf16_t* vp = VT + (16 * vc) * 72 + vs;
                vp[0 * 72] = (bf16_t)(cva.x & 0xffffu); vp[1 * 72] = (bf16_t)(cva.x >> 16); vp[2 * 72] = (bf16_t)(cva.y & 0xffffu); vp[3 * 72] = (bf16_t)(cva.y >> 16);
                vp[4 * 72] = (bf16_t)(cva.z & 0xffffu); vp[5 * 72] = (bf16_t)(cva.z >> 16); vp[6 * 72] = (bf16_t)(cva.w & 0xffffu); vp[7 * 72] = (bf16_t)(cva.w >> 16);
                vp[8 * 72] = (bf16_t)(cvb.x & 0xffffu); vp[9 * 72] = (bf16_t)(cvb.x >> 16); vp[10 * 72] = (bf16_t)(cvb.y & 0xffffu); vp[11 * 72] = (bf16_t)(cvb.y >> 16);
                vp[12 * 72] = (bf16_t)(cvb.z & 0xffffu); vp[13 * 72] = (bf16_t)(cvb.z >> 16); vp[14 * 72] = (bf16_t)(cvb.w & 0xffffu); vp[15 * 72] = (bf16_t)(cvb.w >> 16);
            }
            lds_barrier();
            f32x2 off = {1.f, 1.f}, er = {1.f, 1.f}, ebr = {1.f, 1.f};
#pragma unroll
            for (int gi = 0; gi < 8; ++gi) { const f32x2 gp = *(const f32x2*)(GT + gi * 128 + 2 * kp);
                if (gi < tg) off = off * gp;
                if (gi < 4) er = er * gp; else ebr = ebr * gp; }
            const f32x2 plast = er * ebr;
            const float iera = fast_rcp(fmaxf(er[0], 1e-30f)), ierb = fast_rcp(fmaxf(er[1], 1e-30f));
            float kda[8], kdb[8];
#pragma unroll
            for (int i = 0; i < 8; ++i) {
                const int t = 8 * tg + i; const float pta = off[0] * bl[i][0], ptb = off[1] * bl[i][1];
                const float eqa = fminf(fmaxf(pta * iera, 1e-30f), 1e30f), eqb = fminf(fmaxf(ptb * ierb, 1e-30f), 1e30f);
                const float eka = fast_rcp(eqa), ekb = fast_rcp(eqb);
                const float kea = kk[i][0] * eka, keb = kk[i][1] * ekb;
                *(unsigned*)(QT + t * 136 + 2 * kp) = pk2(qs[i][0] * eqa, qs[i][1] * eqb);
                *(unsigned*)(KT + t * 136 + 2 * kp) = pk2(kea, keb);
                *(unsigned*)(QB + t * 136 + 2 * kp) = pk2(qs[i][0] * pta, qs[i][1] * ptb);
                kda[i] = kea * ebr[0]; kdb[i] = keb * ebr[1];
            }
            *(bf16x8*)(KDT + (2 * kp) * 72 + 8 * tg) = pack8(kda); *(bf16x8*)(KDT + (2 * kp + 1) * 72 + 8 * tg) = pack8(kdb);
            if (tg == 0) *(f32x2*)(BL + 2 * kp) = plast;
        }
        lds_barrier();
#pragma unroll
        for (int q = 0; q < 2; ++q) {
            const int id = 2 * wid + q, ti = id >> 2, si = id & 3;
            f32x4 acc = {0.f, 0.f, 0.f, 0.f};
            if (si <= ti) {
#pragma unroll
                for (int ks = 0; ks < 4; ++ks) { const bf16x8 a = *(const bf16x8*)(QT + (16 * ti + l15) * 136 + 32 * ks + 8 * g); const bf16x8 bb = *(const bf16x8*)(KT + (16 * si + l15) * 136 + 32 * ks + 8 * g); acc = mfma16(a, bb, acc); }
            }
#pragma unroll
            for (int i = 0; i < 4; ++i) { const int t = 16 * ti + 4 * g + i, s = 16 * si + l15; SC[t * 72 + s] = f2bf((s <= t) ? acc[i] : 0.f); }
        }
        f32x4 oacc[4];
        {
            bf16x8 sb[4];
#pragma unroll
            for (int ks = 0; ks < 4; ++ks) { float f[8];
#pragma unroll
                for (int j = 0; j < 4; ++j) { f[j] = S[2 * ks][j]; f[4 + j] = S[2 * ks + 1][j]; }
                sb[ks] = pack8(f); }
#pragma unroll
            for (int mt = 0; mt < 4; ++mt) {
                f32x4 acc = {0.f, 0.f, 0.f, 0.f};
#pragma unroll
                for (int ks = 0; ks < 4; ++ks) { const bf16_t* qp = QB + (16 * mt + l15) * 136 + 32 * ks + 4 * g; const s16x4 lo = *(const s16x4*)qp, hi = *(const s16x4*)(qp + 16);
                    bf16x8 a; a[0] = lo[0]; a[1] = lo[1]; a[2] = lo[2]; a[3] = lo[3]; a[4] = hi[0]; a[5] = hi[1]; a[6] = hi[2]; a[7] = hi[3];
                    acc = mfma16(a, sb[ks], acc); }
                oacc[mt] = acc;
            }
#pragma unroll
            for (int mt = 0; mt < 8; ++mt) {
                const f32x4 e4 = *(const f32x4*)(BL + 16 * mt + 4 * g);
                S[mt] = S[mt] * e4;
#pragma unroll
                for (int ks = 0; ks < 2; ++ks) { const bf16x8 a = *(const bf16x8*)(KDT + (16 * mt + l15) * 72 + 32 * ks + 8 * g); const bf16x8 bv = *(const bf16x8*)(VT + (16 * wid + l15) * 72 + 32 * ks + 8 * g); S[mt] = mfma16(a, bv, S[mt]); }
            }
        }
        lds_barrier();
#pragma unroll
        for (int mt = 0; mt < 4; ++mt) {
            f32x4 acc = oacc[mt];
#pragma unroll
            for (int ks = 0; ks < 2; ++ks) { const bf16x8 a = *(const bf16x8*)(SC + (16 * mt + l15) * 72 + 32 * ks + 8 * g); const bf16x8 bv = *(const bf16x8*)(VT + (16 * wid + l15) * 72 + 32 * ks + 8 * g); acc = mfma16(a, bv, acc); }
#pragma unroll
            for (int i = 0; i < 4; ++i) OL[(16 * mt + 4 * g + i) * 132 + 16 * wid + l15] = acc[i];
        }
        lds_barrier();
        if (c > 0) {
            const size_t row = (size_t)b * SEQ + 64 * (c - 1) + et;
            float o[16]; float ss = 0.f;
#pragma unroll
            for (int i = 0; i < 4; ++i) { const f32x4 v = *(const f32x4*)(OL + et * 132 + 16 * eseg + 4 * i); o[4 * i] = v[0]; o[4 * i + 1] = v[1]; o[4 * i + 2] = v[2]; o[4 * i + 3] = v[3]; }
#pragma unroll
            for (int i = 0; i < 16; ++i) ss += o[i] * o[i];
            ss += shx(ss, 1); ss += shx(ss, 2); ss += shx(ss, 4);
            const float rs = __builtin_amdgcn_rsqf(ss * (1.f / 128.f) + RMS_EPS);
            float hg[16]; unpack8(cga, hg); unpack8(cgb, hg + 8);
            float gn[16];
#pragma unroll
            for (int i = 0; i < 4; ++i) { const f32x4 v = *(const f32x4*)(GNL + 16 * eseg + 4 * i); gn[4 * i] = v[0]; gn[4 * i + 1] = v[1]; gn[4 * i + 2] = v[2]; gn[4 * i + 3] = v[3]; }
            float outv[16];
#pragma unroll
            for (int i = 0; i < 16; ++i) outv[i] = o[i] * rs * gn[i] * hg[i];
            bf16_t* op = MIX + row * D + 1024 + h * 128 + 16 * eseg;
            *(bf16x8*)op = pack8(outv); *(bf16x8*)(op + 8) = pack8(outv + 8);
        }
    }
}

DI int sortable(float f) { const int b = __float_as_int(f); return b ^ ((b >> 31) & 0x7fffffff); }
DI float unsortable(int k) { return __int_as_float(k ^ ((k >> 31) & 0x7fffffff)); }
#define TOPK_INSERT(top, xval) do { int _x = (xval); _Pragma("unroll") for (int _j = 0; _j < 16; ++_j) { const int _hi = max((top)[_j], _x); _x = min((top)[_j], _x); (top)[_j] = _hi; } } while (0)

DI void cex_desc(int& hi, int& lo) { const int a = max(hi, lo), b = min(hi, lo); hi = a; lo = b; }
DI void bitonic_sort16_desc(int (&a)[16]) {
#pragma unroll
    for (int k = 2; k <= 16; k <<= 1)
#pragma unroll
        for (int j = k >> 1; j > 0; j >>= 1)
#pragma unroll
            for (int i = 0; i < 16; ++i) { const int l = i ^ j; if (l > i) { if ((i & k) == 0) cex_desc(a[i], a[l]); else cex_desc(a[l], a[i]); } }
}
DI void merge_top16(int (&top)[16], const int (&g)[16]) {
#pragma unroll
    for (int i = 0; i < 16; ++i) top[i] = max(top[i], g[15 - i]);
#pragma unroll
    for (int j = 8; j > 0; j >>= 1)
#pragma unroll
        for (int i = 0; i < 16; ++i) { const int l = i ^ j; if (l > i) cex_desc(top[i], top[l]); }
}
DI void peer_unit(const Params& p, unsigned char* lds, int unit, const int mode = 0) {
    const int t0 = unit * 32;
    int* SELI = (int*)lds;
    float* SELG = (float*)(lds + 16384);
    const int tid = threadIdx.x, lane = tid & 63, wid = tid >> 6, h5 = lane >> 5, l31 = lane & 31;
    const bf16_t* pq = (const bf16_t*)(p.ws + OFF_PROJ);
    const bf16_t* skb = (const bf16_t*)(p.ws + OFF_SK);
    const bf16_t* XN = (const bf16_t*)(p.ws + OFF_HN);
    const bf16_t* UB = (const bf16_t*)(p.ws + OFF_UB);
    const bf16_t* VB = (const bf16_t*)(p.ws + OFF_VB);
    float* RSL = (float*)(lds + 32768);
    if (mode != 2) {
    for (int q = 0; q < 4; ++q) {
        const int tl = 4 * wid + q; const bf16_t* xp = XN + ((size_t)t0 + tl) * D + 16 * lane; float ss = 0.f;
#pragma unroll
        for (int r = 0; r < 2; ++r) { float f[16]; unpack8(*(const u32x4*)(xp + 1024 * r), f); unpack8(*(const u32x4*)(xp + 1024 * r + 8), f + 8);
#pragma unroll
            for (int i = 0; i < 16; ++i) ss += f[i] * f[i]; }
#pragma unroll
        for (int m = 1; m < 64; m <<= 1) ss += shx(ss, m);
        if (lane == 0) RSL[tl] = __builtin_amdgcn_rsqf(ss * (1.f / 2048.f) + RMS_EPS);
    }
    __syncthreads();
    {
        const int hd = wid; const size_t tok = (size_t)t0 + l31; const float rstok = RSL[l31];
        int top0[16], top1[16];
#pragma unroll
        for (int c = 0; c < 2; ++c) {
            int top[16];
#pragma unroll
            for (int j = 0; j < 16; ++j) top[j] = (int)0x80000000;
            bf16x8 qf[8];
#pragma unroll
            for (int ks = 0; ks < 8; ++ks) qf[ks] = __builtin_nontemporal_load((const bf16x8*)(pq + tok * D + (hd * 2 + c) * 128 + 16 * ks + 8 * h5));
            bf16x8 kf[8];
#pragma unroll
            for (int ks = 0; ks < 8; ++ks) kf[ks] = *(const bf16x8*)(skb + (size_t)((hd * 2 + c) * 128 + l31) * 128 + 16 * ks + 8 * h5);
#pragma unroll 1
            for (int mt = 0; mt < 4; ++mt) {
                bf16x8 kn[8]; const int mn = mt < 3 ? mt + 1 : mt;
#pragma unroll
                for (int ks = 0; ks < 8; ++ks) kn[ks] = *(const bf16x8*)(skb + (size_t)((hd * 2 + c) * 128 + 32 * mn + l31) * 128 + 16 * ks + 8 * h5);
                f32x16 acc;
#pragma unroll
                for (int r = 0; r < 16; ++r) acc[r] = 0.f;
#pragma unroll
                for (int ks = 0; ks < 8; ++ks) acc = mfma32(kf[ks], qf[ks], acc);
#pragma unroll
                for (int ks = 0; ks < 8; ++ks) kf[ks] = kn[ks];
                int grp[16];
#pragma unroll
                for (int r = 0; r < 16; ++r) { const int n = 32 * mt + (r & 3) + 8 * (r >> 2) + 4 * h5; grp[r] = (sortable(acc[r]) & ~127) | n; }
                bitonic_sort16_desc(grp); merge_top16(top, grp);
            }
            int other[16];
#pragma unroll
            for (int j = 0; j < 16; ++j) other[j] = shxi(top[j], 32);
            merge_top16(top, other);
#pragma unroll
            for (int j = 0; j < 16; ++j) { if (c == 0) top0[j] = top[j]; else top1[j] = top[j]; }
        }
        float v1[16], v2[16];
#pragma unroll
        for (int j = 0; j < 16; ++j) { v1[j] = unsortable(top0[j] & ~127); v2[j] = unsortable(top1[j] & ~127); }
        int c0[16], c1[16], c2[16], c3[16];
#pragma unroll
        for (int j = 0; j < 16; ++j) { c3[j] = (int)0x80000000; }
#pragma unroll
        for (int i = 0; i < 16; ++i)
#pragma unroll
            for (int j = 0; j < 16; ++j)
                if ((i + 1) * (j + 1) <= 16) {
                    int idx = j;
#pragma unroll
                    for (int a = 0; a < 16; ++a) if (a < i) idx += 16 / (a + 1);
                    const float val = v1[i] + v2[j]; const int key = (sortable(val) & ~255) | (i << 4) | j;
                    if (idx < 16) c0[idx] = key; else if (idx < 32) c1[idx - 16] = key; else if (idx < 48) c2[idx - 32] = key; else c3[idx - 48] = key;
                }
        bitonic_sort16_desc(c0); bitonic_sort16_desc(c1); bitonic_sort16_desc(c2); bitonic_sort16_desc(c3);
        merge_top16(c0, c1); merge_top16(c2, c3); merge_top16(c0, c2);
        int best[16];
#pragma unroll
        for (int j = 0; j < 16; ++j) best[j] = c0[j];
        unsigned char* IDXB = lds + 34816 + wid * 2048; unsigned* IDXW = (unsigned*)IDXB;
#pragma unroll
        for (int jq = 0; jq < 4; ++jq) {
            IDXW[jq * 64 + lane] = (unsigned)(top0[4 * jq] & 127) | ((unsigned)(top0[4 * jq + 1] & 127) << 8) | ((unsigned)(top0[4 * jq + 2] & 127) << 16) | ((unsigned)(top0[4 * jq + 3] & 127) << 24);
            IDXW[(4 + jq) * 64 + lane] = (unsigned)(top1[4 * jq] & 127) | ((unsigned)(top1[4 * jq + 1] & 127) << 8) | ((unsigned)(top1[4 * jq + 2] & 127) << 16) | ((unsigned)(top1[4 * jq + 3] & 127) << 24);
        }
        const float mval = unsortable(best[0] & ~255);
        float ev[16]; int ei[16]; float sum = 0.f;
#pragma unroll
        for (int kx = 0; kx < 16; ++kx) {
            const int ij = best[kx] & 255, i = ij >> 4, j = ij & 15;
            const int n1 = IDXB[((i >> 2) * 64 + lane) * 4 + (i & 3)], n2 = IDXB[((4 + (j >> 2)) * 64 + lane) * 4 + (j & 3)];
            ei[kx] = n1 * 128 + n2; ev[kx] = fast_exp((unsortable(best[kx] & ~255) - mval) * rstok); sum += ev[kx];
        }
        const float rsum = 1.f / sum;
        if (lane < 32) {
#pragma unroll
            for (int kx = 0; kx < 16; ++kx) { SELI[l31 * 128 + hd * 16 + kx] = ei[kx]; SELG[l31 * 128 + hd * 16 + kx] = ev[kx] * rsum; }
        }
    }
    }
    __syncthreads();
    if (mode != 1) {
    const unsigned char* UBq = p.ws + OFF_UB; const unsigned char* VBq = p.ws + OFF_VB; const float* SU = (const float*)(p.ws + OFF_SU); const float* SV = (const float*)(p.ws + OFF_SV);
    for (int q = 0; q < 4; ++q) {
        const int tl = 4 * wid + q; const size_t tok = (size_t)t0 + tl;
        unsigned xq[8]; float sx; float sumx;
        {
            float xf[32];
            const bf16_t* xp = XN + tok * D + 4 * lane;
#pragma unroll
            for (int i = 0; i < 8; ++i) { const u32x2 w = *(const u32x2*)(xp + 256 * i); xf[4 * i] = bf_lo(w.x); xf[4 * i + 1] = bf_hi(w.x); xf[4 * i + 2] = bf_lo(w.y); xf[4 * i + 3] = bf_hi(w.y); }
            float am = 0.f;
#pragma unroll
            for (int i = 0; i < 32; ++i) am = fmaxf(am, fabsf(xf[i]));
#pragma unroll
            for (int m = 1; m < 64; m <<= 1) am = fmaxf(am, shx(am, m));
            const float inv = am > 0.f ? 127.f / am : 0.f; sx = am * (1.f / 127.f);
            int isum = 0;
#pragma unroll
            for (int i = 0; i < 8; ++i) { const float* f = xf + 4 * i;
                const int q0 = (int)rintf(f[0] * inv), q1 = (int)rintf(f[1] * inv), q2 = (int)rintf(f[2] * inv), q3 = (int)rintf(f[3] * inv); isum += q0 + q1 + q2 + q3;
                xq[i] = (unsigned)(q0 & 0xff) | ((unsigned)(q1 & 0xff) << 8) | ((unsigned)(q2 & 0xff) << 16) | ((unsigned)(q3 & 0xff) << 24); }
            sumx = (float)isum;
#pragma unroll
            for (int m = 1; m < 64; m <<= 1) sumx += shx(sumx, m);
        }
        const int e_lo = SELI[tl * 128 + lane], e_hi = SELI[tl * 128 + 64 + lane];
        const float g_lo = SELG[tl * 128 + lane], g_hi = SELG[tl * 128 + 64 + lane];
        const float sxr = sx * RSL[tl];
        const float su_lo = SU[e_lo] * sxr, su_hi = SU[e_hi] * sxr, sv_lo = SV[e_lo], sv_hi = SV[e_hi];
        float a_lo = 0.f, a_hi = 0.f;
        u32x4 B0[8], B1[8];
        auto loadRows = [&](u32x4 (&buf)[8], const unsigned char* tab, int j) {
            const int esrc = j < 8 ? e_lo : e_hi;
#pragma unroll
            for (int i = 0; i < 8; ++i) { const int eid = __builtin_amdgcn_readlane(esrc, (j & 7) * 8 + i); buf[i] = *(const u32x4*)(tab + (size_t)eid * 1024 + 16 * lane); }
        };
        auto procU = [&](const u32x4 (&buf)[8], int j) {
            float ps[8];
#pragma unroll
            for (int i = 0; i < 8; ++i) { const u32x4 uu = buf[i]; int acc = 0;
#pragma unroll
                for (int d = 0; d < 4; ++d) { const unsigned wv = uu[d];
                    acc = __builtin_amdgcn_sdot4((int)(wv & 0x0f0f0f0fu), (int)xq[2 * d], acc, false); acc = __builtin_amdgcn_sdot4((int)((wv >> 4) & 0x0f0f0f0fu), (int)xq[2 * d + 1], acc, false); }
                ps[i] = (float)acc; }
            float q1[4], q2[2];
#pragma unroll
            for (int i = 0; i < 4; ++i) { const bool o = lane & 1; const float keep = o ? ps[2 * i + 1] : ps[2 * i], send = o ? ps[2 * i] : ps[2 * i + 1]; q1[i] = keep + shx(send, 1); }
#pragma unroll
            for (int i = 0; i < 2; ++i) { const bool o = lane & 2; const float keep = o ? q1[2 * i + 1] : q1[2 * i], send = o ? q1[2 * i] : q1[2 * i + 1]; q2[i] = keep + shx(send, 2); }
            float q3; { const bool o = lane & 4; const float keep = o ? q2[1] : q2[0], send = o ? q2[0] : q2[1]; q3 = keep + shx(send, 4); }
            q3 += shx(q3, 8); q3 += shx(q3, 16); q3 += shx(q3, 32);
            if ((lane >> 3) == (j & 7)) { if (j < 8) a_lo = q3; else a_hi = q3; }
        };
        float hh[2] = {0.f, 0.f};
        loadRows(B0, UBq, 0); loadRows(B1, UBq, 1);
#pragma unroll 1
        for (int jj = 0; jj < 16; jj += 2) {
            procU(B0, jj);     if (jj + 2 < 16) loadRows(B0, UBq, jj + 2);
            procU(B1, jj + 1); if (jj + 3 < 16) loadRows(B1, UBq, jj + 3);
        }
        a_lo -= 7.5f * sumx; a_hi -= 7.5f * sumx;
        {
            const float av[2] = {a_lo * su_lo, a_hi * su_hi}; const float gv[2] = {g_lo * sv_lo, g_hi * sv_hi};
#pragma unroll
            for (int i = 0; i < 2; ++i) { const float a = av[i]; const float y = 0.7978845608028654f * (a + 0.044715f * a * a * a);
                const float th = 1.f - 2.f * fast_rcp(1.f + fast_exp(2.f * y)); hh[i] = 0.5f * a * (1.f + th) * gv[i]; }
        }
        {
            float* HE = (float*)(p.ws + OFF_HE) + tok * 128; int* EI = (int*)(p.ws + OFF_EI) + tok * 128;
            HE[lane] = hh[0]; HE[64 + lane] = hh[1]; EI[lane] = e_lo; EI[64 + lane] = e_hi;
        }
    }
    }
    __syncthreads();
}


DI void peer_unit_B(const Params& p, int unit) {
    const int t0 = unit * 32; const int tid = threadIdx.x, lane = tid & 63, wid = tid >> 6;
    const bf16_t* XN = (const bf16_t*)(p.ws + OFF_HN); const unsigned char* VBq = p.ws + OFF_VB;
    const float* HEb = (const float*)(p.ws + OFF_HE); const int* EIb = (const int*)(p.ws + OFF_EI);
    int e_lo = EIb[((size_t)t0 + 4 * wid) * 128 + lane], e_hi = EIb[((size_t)t0 + 4 * wid) * 128 + 64 + lane];
    float h_lo = HEb[((size_t)t0 + 4 * wid) * 128 + lane], h_hi = HEb[((size_t)t0 + 4 * wid) * 128 + 64 + lane];
    u32x4 B0[8], B1[8], B2[8];
    auto loadRows = [&](u32x4 (&buf)[8], int j, int elo, int ehi) {
        const int esrc = j < 8 ? elo : ehi;
#pragma unroll
        for (int i = 0; i < 8; ++i) { const int eid = __builtin_amdgcn_readlane(esrc, (j & 7) * 8 + i); buf[i] = *(const u32x4*)(VBq + (size_t)eid * 1024 + 16 * lane); }
    };
    loadRows(B0, 0, e_lo, e_hi); loadRows(B1, 1, e_lo, e_hi); loadRows(B2, 2, e_lo, e_hi);
    for (int q = 0; q < 4; ++q) {
        const size_t tok = (size_t)t0 + 4 * wid + q; const size_t tn = (q < 3) ? tok + 1 : tok;
        const int ne_lo = EIb[tn * 128 + lane], ne_hi = EIb[tn * 128 + 64 + lane]; const float nh_lo = HEb[tn * 128 + lane], nh_hi = HEb[tn * 128 + 64 + lane];
        f32x2 acc[16];
#pragma unroll
        for (int i = 0; i < 16; ++i) acc[i] = (f32x2){0.f, 0.f};
        auto procV = [&](const u32x4 (&buf)[8], int j) {
            const float hsrc = j < 8 ? h_lo : h_hi;
#pragma unroll
            for (int i = 0; i < 8; ++i) {
                const float hv = __int_as_float(__builtin_amdgcn_readlane(__float_as_int(hsrc), (j & 7) * 8 + i));
                const f32x2 hv2 = {hv, hv}; const u32x4 vv = buf[i];
#pragma unroll
                for (int d = 0; d < 4; ++d) { const unsigned wv = vv[d];
                    acc[4 * d + 0] += hv2 * __builtin_amdgcn_cvt_scalef32_pk_f32_fp4(wv, 1.0f, 0); acc[4 * d + 1] += hv2 * __builtin_amdgcn_cvt_scalef32_pk_f32_fp4(wv, 1.0f, 1);
                    acc[4 * d + 2] += hv2 * __builtin_amdgcn_cvt_scalef32_pk_f32_fp4(wv, 1.0f, 2); acc[4 * d + 3] += hv2 * __builtin_amdgcn_cvt_scalef32_pk_f32_fp4(wv, 1.0f, 3); }
            }
        };
#pragma unroll 1
        for (int jj = 0; jj < 15; jj += 3) {
            procV(B0, jj);     if (jj + 3 < 16) loadRows(B0, jj + 3, e_lo, e_hi);
            procV(B1, jj + 1); if (jj + 4 < 16) loadRows(B1, jj + 4, e_lo, e_hi); else if (q < 3) loadRows(B1, 1, ne_lo, ne_hi);
            procV(B2, jj + 2); if (jj + 5 < 16) loadRows(B2, jj + 5, e_lo, e_hi); else if (q < 3) loadRows(B2, 2, ne_lo, ne_hi);
        }
        procV(B0, 15); if (q < 3) loadRows(B0, 0, ne_lo, ne_hi);
        float* orow = p.out + tok * D + 4 * lane; const bf16_t* hrow = XN + tok * D + 4 * lane;
#pragma unroll
        for (int i = 0; i < 8; ++i) { const u32x2 hw = __builtin_nontemporal_load((const u32x2*)(hrow + 256 * i)); f32x4 a;
            a[0] = bf_lo(hw.x) + acc[2 * i][0]; a[1] = bf_hi(hw.x) + acc[2 * i][1]; a[2] = bf_lo(hw.y) + acc[2 * i + 1][0]; a[3] = bf_hi(hw.y) + acc[2 * i + 1][1];
            __builtin_nontemporal_store(a, (f32x4*)(orow + 256 * i)); }
        e_lo = ne_lo; e_hi = ne_hi; h_lo = nh_lo; h_hi = nh_hi;
    }
}

#define XB_TMO      128
#define XB_XCNT(j)  (256  + 64 * (j))
#define XB_XSUB(j)  (1280 + 64 * (j))
#define XB_XGEN(j)  (2304 + 64 * (j))
#define XB_TOP      3328
#define XB_TOPGEN   3392
#define XCD_BAR_WORDS 3456
#define XB_SPIN_CAP (1u << 20)
DI unsigned xb_ld(unsigned* p)              { return __hip_atomic_load(p, __ATOMIC_RELAXED, __HIP_MEMORY_SCOPE_AGENT); }
DI unsigned xb_add(unsigned* p, unsigned v) { return __hip_atomic_fetch_add(p, v, __ATOMIC_RELAXED, __HIP_MEMORY_SCOPE_AGENT); }
DI unsigned xb_xcc_id() { return (unsigned)__builtin_amdgcn_s_getreg((3 << 11) | 20) & 0xFu; }
#define XB_SPIN(cond, bar) do { unsigned _sp = 0; while (cond) { __builtin_amdgcn_s_sleep(1); \
    if ((++_sp & 255u) == 0u) { if (xb_ld(&(bar)[XB_TMO])) break; if (_sp > XB_SPIN_CAP) { atomicAdd(&(bar)[XB_TMO], 1u); break; } } } } while (0)
struct XcdBarrier { unsigned* bar; unsigned x; volatile LAS unsigned* st; };
DI XcdBarrier xcd_barrier_post(unsigned* bar, volatile LAS unsigned* st) {
    XcdBarrier b; b.bar = bar; b.x = xb_xcc_id(); b.st = st;
    if (threadIdx.x == 0) (void)xb_add(&bar[XB_XCNT(b.x)], 1u);
    return b;
}
DI void xcd_barrier_complete(unsigned* bar, unsigned x, unsigned& nloc, unsigned& nx) {
    const unsigned G = gridDim.x * gridDim.y * gridDim.z;
    unsigned sum, cnt, mine, sp = 0u;
    for (;;) {
        sum = 0u; cnt = 0u; mine = 0u;
#pragma unroll
        for (unsigned j = 0; j < 16; ++j) { const unsigned c = xb_ld(&bar[XB_XCNT(j)]); sum += c; cnt += (c > 0u) ? 1u : 0u; mine = (j == x) ? c : mine; }
        if (sum == G) break;
        __builtin_amdgcn_s_sleep(1);
        if ((++sp & 255u) == 0u) { if (xb_ld(&bar[XB_TMO])) break; if (sp > XB_SPIN_CAP) { atomicAdd(&bar[XB_TMO], 1u); break; } }
    }
    nloc = mine > 0u ? mine : 1u; nx = cnt > 0u ? cnt : 1u;
}
DI void xcd_barrier(const XcdBarrier& b) {
    asm volatile("s_waitcnt vmcnt(0)" ::: "memory");
    __syncthreads();
    if (threadIdx.x == 0) {
        unsigned* bar = b.bar;
        __builtin_amdgcn_s_waitcnt(0);
        unsigned nloc = b.st[0], nx = b.st[1];
        if (nloc == 0u) { xcd_barrier_complete(bar, b.x, nloc, nx); b.st[0] = nloc; b.st[1] = nx; }
        const unsigned old = xb_add(&bar[XB_XSUB(b.x)], 1u);
        const unsigned gen = old / nloc;
        if (old + 1u == (gen + 1u) * nloc) {
            __builtin_amdgcn_fence(__ATOMIC_RELEASE, "agent");
            asm volatile("s_waitcnt vmcnt(0)" ::: "memory");
            const unsigned og = xb_add(&bar[XB_TOP], 1u);
            const unsigned tg = og / nx;
            if (og + 1u == (tg + 1u) * nx) xb_add(&bar[XB_TOPGEN], 1u);
            else XB_SPIN(xb_ld(&bar[XB_TOPGEN]) == tg, bar);
            __builtin_amdgcn_fence(__ATOMIC_ACQUIRE, "agent");
            xb_add(&bar[XB_XGEN(b.x)], 1u);
            asm volatile("s_waitcnt vmcnt(0)" ::: "memory");
        } else {
            XB_SPIN(xb_ld(&bar[XB_XGEN(b.x)]) == gen, bar);
            __builtin_amdgcn_fence(__ATOMIC_ACQUIRE, "agent");
            asm volatile("s_waitcnt vmcnt(0)" ::: "memory");
        }
    }
    __syncthreads();
}

template <int MODE>
__global__ __launch_bounds__(512, 2) void fwd_kernel(Params p) {
    extern __shared__ __attribute__((aligned(16))) unsigned char shm[];
    const int bid = blockIdx.x, nb = gridDim.x;
    XcdBarrier xb{};
    if constexpr (MODE < 0) {
        volatile LAS unsigned* st = (volatile LAS unsigned*)((LAS unsigned char*)shm + (DYN_LDS - 16));
        if (threadIdx.x == 0) { st[0] = 0u; st[1] = 0u; }
        __syncthreads();
        xb = xcd_barrier_post((unsigned*)(p.ws + OFF_XBAR), st);
    }
    if constexpr (MODE < 0 || MODE == 0) phase0(p, shm, bid, nb, 0);
    if constexpr (MODE < 0) { if (p.ws == nullptr) cg::this_grid().sync();
        xcd_barrier(xb); }
    if constexpr (MODE < 0 || MODE == 1) {
        pg8::StaticOrder S; S.init(MROWS, INC, nb, bid);
        pg8::EpiBf16 E{(bf16_t*)(p.ws + OFF_PROJ), INC, 1};
        pg8::gemm_phase((LAS unsigned char*)shm, pg8::Gemm{(const bf16_t*)(p.ws + OFF_HN), (const bf16_t*)(p.ws + OFF_WINT), MROWS, INC, D}, S, E);
    }
#if REP == 1
    if constexpr (MODE < 0) { __syncthreads();
        pg8::StaticOrder S; S.init(MROWS, INC, nb, bid);
        pg8::EpiBf16 E{(bf16_t*)(p.ws + OFF_PROJ), INC, 1};
        pg8::gemm_phase((LAS unsigned char*)shm, pg8::Gemm{(const bf16_t*)(p.ws + OFF_HN), (const bf16_t*)(p.ws + OFF_WINT), MROWS, INC, D}, S, E); }
#endif
    if constexpr (MODE < 0) xcd_barrier(xb);
    if constexpr (MODE < 0 || MODE == 2) {
        if (nb >= 128) { if (bid < 64) hgrn_item(p, shm, bid); else { for (int it = bid - 64; it < 256; it += nb - 64) attn_item(p, shm, it); phase0(p, shm, bid - 64, nb - 64, 1); } }
        else { for (int it = bid; it < 64; it += nb) hgrn_item(p, shm, it); for (int it = bid; it < 256; it += nb) attn_item(p, shm, it); phase0(p, shm, bid, nb, 1); }
    }
#if REP == 2
    if constexpr (MODE < 0) { __syncthreads(); if (bid < 64) hgrn_item(p, shm, bid); else for (int it = bid - 64; it < 256; it += nb - 64) attn_item(p, shm, it); }
#endif
    if constexpr (MODE < 0) xcd_barrier(xb);
    if constexpr (MODE < 0 || MODE == 3) {
        pg8::StaticOrder S; S.init(T, D, nb, bid);
        pg8::EpiBf16Res E{(bf16_t*)(p.ws + OFF_HN), p.x, D};
        pg8::gemm_phase((LAS unsigned char*)shm, pg8::Gemm{(const bf16_t*)(p.ws + OFF_MIX), (const bf16_t*)(p.ws + OFF_WOUTT), T, D, D}, S, E);
    }
    if constexpr (MODE < 0) xcd_barrier(xb);
    if constexpr (MODE < 0 || MODE == 5) {
        pg8::StaticOrder S; S.init(T, D, nb, bid);
        pg8::EpiBf16 E{(bf16_t*)(p.ws + OFF_PROJ), D, 0};
        pg8::gemm_phase((LAS unsigned char*)shm, pg8::Gemm{(const bf16_t*)(p.ws + OFF_HN), (const bf16_t*)(p.ws + OFF_WQT), T, D, D}, S, E);
    }
    if constexpr (MODE < 0) xcd_barrier(xb);
#if REP == 6
    if constexpr (MODE < 0) { for (int u = bid; u < T / 32; u += nb) peer_unit(p, shm, u, true); }
#endif
    if constexpr (MODE < 0 || MODE == 6) {
        if (nb == 256 && ((bid >> 3) & 1)) {
            peer_unit(p, shm, bid, 1); peer_unit(p, shm + 51200, bid + nb, 1); peer_unit(p, shm, bid, 2); peer_unit(p, shm + 51200, bid + nb, 2);
        } else { for (int u = bid; u < T / 32; u += nb) peer_unit(p, shm, u); }
    }
    if constexpr (MODE < 0 || MODE == 6) { for (int u = bid; u < T / 32; u += nb) peer_unit_B(p, u); }
}

template <int MODE> static void launch_plain(const Params& p, int grid, hipStream_t stream) {
    hipFuncSetAttribute((const void*)fwd_kernel<MODE>, hipFuncAttributeMaxDynamicSharedMemorySize, DYN_LDS);
    hipLaunchKernelGGL((fwd_kernel<MODE>), dim3(grid), dim3(512), DYN_LDS, stream, p);
}

extern "C" void kernel_launch(void* const* d_in, const int* in_sizes, int n_in, void* d_out, int out_size, void* d_ws, size_t ws_size, hipStream_t stream) {
    if (ws_size < WS_NEED) { fprintf(stderr, "workspace too small: %zu < %zu\n", ws_size, WS_NEED); return; }
    Params p{};
    p.x = (const float*)d_in[0]; p.meta = (const float*)d_in[1]; p.lb_logits = (const float*)d_in[2]; p.ln_mix_g = (const float*)d_in[3]; p.w_in = (const float*)d_in[4];
    p.q_norm_g = (const float*)d_in[5]; p.k_norm_g = (const float*)d_in[6]; p.sinks = (const float*)d_in[7]; p.hgrn_norm_g = (const float*)d_in[8]; p.w_out = (const float*)d_in[9];
    p.ln_ffn_g = (const float*)d_in[10]; p.peer_wq = (const float*)d_in[11]; p.sub_keys = (const float*)d_in[12]; p.peer_u = (const float*)d_in[13]; p.peer_v = (const float*)d_in[14];
    p.out = (float*)d_out; p.ws = (unsigned char*)d_ws;
#if MK_SINGLE
    static int grid_blocks = 0;
    if (!grid_blocks) {
        hipFuncSetAttribute((const void*)fwd_kernel<-1>, hipFuncAttributeMaxDynamicSharedMemorySize, DYN_LDS);
        int dev = 0, cus = 0, per_cu = 0; hipGetDevice(&dev); hipDeviceGetAttribute(&cus, hipDeviceAttributeMultiprocessorCount, dev);
        hipOccupancyMaxActiveBlocksPerMultiprocessor(&per_cu, fwd_kernel<-1>, 512, DYN_LDS);
        if (per_cu > 1) per_cu = 1;
        grid_blocks = cus * per_cu;
    }
    hipMemsetAsync((char*)d_ws + OFF_XBAR, 0, XCD_BAR_WORDS * 4, stream);
    void* args[] = {&p};
    hipError_t e = hipLaunchCooperativeKernel((void*)fwd_kernel<-1>, dim3(grid_blocks), dim3(512), args, DYN_LDS, stream);
    if (e != hipSuccess) fprintf(stderr, "cooperative launch failed: %s (grid %d)\n", hipGetErrorString(e), grid_blocks);
#else
    launch_plain<0>(p, 256, stream); launch_plain<1>(p, 256, stream); launch_plain<2>(p, 256, stream); launch_plain<3>(p, 256, stream);
    launch_plain<4>(p, 256, stream); launch_plain<5>(p, 256, stream); launch_plain<6>(p, 256, stream);
#endif
}
```

```cpp
#include <hip/hip_runtime.h>
#include <hip/hip_cooperative_groups.h>
#include <cstdio>
namespace cg = cooperative_groups;

#ifndef REP
#define REP 0
#endif
#ifndef MK_SINGLE
#define MK_SINGLE 1
#endif

#define LAS __attribute__((address_space(3)))
#define DI __device__ __forceinline__
typedef unsigned short bf16_t;
typedef short bf16x8 __attribute__((ext_vector_type(8)));
typedef short s16x4 __attribute__((ext_vector_type(4)));
typedef float f32x4 __attribute__((ext_vector_type(4)));
typedef float f32x16 __attribute__((ext_vector_type(16)));
typedef unsigned u32x4 __attribute__((ext_vector_type(4)));
typedef unsigned u32x2 __attribute__((ext_vector_type(2)));
typedef __bf16 bf16x2_t __attribute__((ext_vector_type(2)));
typedef float f32x2 __attribute__((ext_vector_type(2)));

constexpr int D = 2048, SEQ = 2048, T = 16384, NMETA = 16, MROWS = 16640, INC = 5632;
constexpr int COL_K = 1024, COL_V = 1280, COL_HQ = 1536, COL_HF = 2560, COL_HI = 3584, COL_HG = 4608;
constexpr float RMS_EPS = 1e-6f;
constexpr float LOG2E = 1.4426950408889634f;

constexpr size_t OFF_WINT = 0;
constexpr size_t OFF_WOUTT = OFF_WINT + (size_t)INC * D * 2;
constexpr size_t OFF_WQT = OFF_WOUTT + (size_t)D * D * 2;
constexpr size_t OFF_HN = OFF_WQT + (size_t)D * D * 2;
constexpr size_t OFF_PROJ = OFF_HN + (size_t)MROWS * D * 2;
constexpr size_t OFF_MIX = OFF_PROJ + (size_t)MROWS * INC * 2;
constexpr size_t OFF_UB = OFF_MIX + (size_t)T * D * 2;
constexpr size_t OFF_VB = OFF_UB + (size_t)16384 * D * 2;
constexpr size_t OFF_SK = OFF_VB + (size_t)16384 * D * 2;
constexpr size_t OFF_ROPE = OFF_SK + (size_t)262144 * 2;
constexpr size_t OFF_LB = OFF_ROPE + (size_t)2064 * 32 * 4;
constexpr size_t OFF_SU = OFF_LB + 4096;
constexpr size_t OFF_SV = OFF_SU + 65536;
constexpr size_t OFF_XBAR = OFF_SV + 65536;
constexpr size_t OFF_HE = OFF_XBAR + 16384;
constexpr size_t OFF_EI = OFF_HE + (size_t)T * 128 * 4;
constexpr size_t WS_NEED = OFF_EI + (size_t)T * 128 * 4;
constexpr int DYN_LDS = 155648;

struct Params {
    const float *x, *meta, *lb_logits, *ln_mix_g, *w_in, *q_norm_g, *k_norm_g, *sinks, *hgrn_norm_g, *w_out, *ln_ffn_g, *peer_wq, *sub_keys, *peer_u, *peer_v;
    float* out;
    unsigned char* ws;
};

DI unsigned pk2(float a, float b) { f32x2 v = {a, b}; bf16x2_t r = __builtin_convertvector(v, bf16x2_t); return __builtin_bit_cast(unsigned, r); }
DI bf16_t f2bf(float a) { return (bf16_t)(pk2(a, 0.f) & 0xffffu); }
DI float bf_lo(unsigned u) { return __uint_as_float(u << 16); }
DI float bf_hi(unsigned u) { return __uint_as_float(u & 0xffff0000u); }
DI float bf2f(bf16_t h) { return __uint_as_float(((unsigned)h) << 16); }
DI float shx(float v, int m) { return __shfl_xor(v, m, 64); }
DI int shxi(int v, int m) { return __shfl_xor(v, m, 64); }
DI float fast_exp(float x) { return __builtin_amdgcn_exp2f(x * LOG2E); }
DI float fast_rcp(float x) { return __builtin_amdgcn_rcpf(x); }
DI float dot2u(unsigned w, unsigned x, float acc) { return __builtin_amdgcn_fdot2_f32_bf16(__builtin_bit_cast(bf16x2_t, w), __builtin_bit_cast(bf16x2_t, x), acc, false); }
DI f32x16 mfma32(bf16x8 a, bf16x8 b, f32x16 c) { return __builtin_amdgcn_mfma_f32_32x32x16_bf16(a, b, c, 0, 0, 0); }
DI f32x4 mfma16(bf16x8 a, bf16x8 b, f32x4 c) { return __builtin_amdgcn_mfma_f32_16x16x32_bf16(a, b, c, 0, 0, 0); }
DI bf16x8 pack8(const float* f) { u32x4 w; w.x = pk2(f[0], f[1]); w.y = pk2(f[2], f[3]); w.z = pk2(f[4], f[5]); w.w = pk2(f[6], f[7]); return __builtin_bit_cast(bf16x8, w); }
DI void unpack8(u32x4 w, float* f) { f[0] = bf_lo(w.x); f[1] = bf_hi(w.x); f[2] = bf_lo(w.y); f[3] = bf_hi(w.y); f[4] = bf_lo(w.z); f[5] = bf_hi(w.z); f[6] = bf_lo(w.w); f[7] = bf_hi(w.w); }

namespace pg8 {
constexpr int BM = 256, BK = 64, HALF = 128, HTB = HALF * BK * 2, STAGE_BYTES = 8 * HTB, NXCD = 8, WGM = 8;
DI int lds_byte(int r, int c) { const int st = (r >> 4) * 2 + (c >> 5), rr = r & 15, cc = c & 31, ob = rr * 64 + cc * 2; return st * 1024 + (ob ^ (((ob >> 9) & 1) << 5)); }
DI void stage_rc(int b, int& R, int& C) { const int st = b / 1024, sb = b % 1024, swz = sb ^ (((sb >> 9) & 1) << 5); R = (st >> 1) * 16 + swz / 64; C = (st & 1) * 32 + (swz % 64) / 2; }
DI int perm32(int rho) { const int n = rho >> 4, i = rho & 15; return 8 * (i >> 2) + 4 * n + (i & 3); }
struct Unit { int pm, pn; };
struct Gemm { const bf16_t* A; const bf16_t* Bt; int M, N, K; };
struct StaticOrder {
    int nM, nN, nwg, G, c;
    DI void init(int M, int N, int G_, int c_) { nM = M / BM; nN = N / BM; nwg = nM * nN; G = G_; c = c_; }
    DI bool next(int i, Unit& u) const {
        const long L = (long)i * G + c; if (L >= nwg) return false;
        int wgid = (int)L; { const int q = nwg / NXCD, r = nwg % NXCD, xcd = wgid % NXCD, off = wgid / NXCD; wgid = (xcd < r ? xcd * (q + 1) : r * (q + 1) + (xcd - r) * q) + off; }
        const int nig = WGM * nN, gid = wgid / nig, fm = gid * WGM, gsz = (nM - fm) < WGM ? (nM - fm) : WGM;
        u.pm = fm + ((wgid % nig) % gsz); u.pn = (wgid % nig) / gsz; return true;
    }
};
struct EpiBf16 {
    static constexpr bool PERM = true;
    bf16_t* O; int ldc; int acts;
    DI void operator()(const f32x4 (&acc)[2][2][4][2], const Unit& u, int wr, int wc, int fr, int fq) const {
        const int row0 = u.pm * BM + wr * 64 + fr; const int col0 = u.pn * BM + wc * 32 + 8 * fq;
        const int kind = !acts ? 0 : (((u.pn >= 6 && u.pn < 10) || u.pn >= 18) ? 1 : ((u.pn >= 10 && u.pn < 14) ? 2 : 0));
#pragma unroll
        for (int ai = 0; ai < 2; ++ai)
#pragma unroll
            for (int m = 0; m < 4; ++m) { bf16_t* rowp = O + (size_t)(row0 + ai * HALF + m * 16) * ldc + col0;
#pragma unroll
                for (int bj = 0; bj < 2; ++bj) { f32x4 v0 = acc[ai][bj][m][0], v1 = acc[ai][bj][m][1];
                    if (kind == 1) {
#pragma unroll
                        for (int j = 0; j < 4; ++j) { v0[j] = v0[j] * fast_rcp(1.f + fast_exp(-v0[j])); v1[j] = v1[j] * fast_rcp(1.f + fast_exp(-v1[j])); } }
                    else if (kind == 2) {
#pragma unroll
                        for (int j = 0; j < 4; ++j) { v0[j] = fast_rcp(1.f + fast_exp(v0[j])); v1[j] = fast_rcp(1.f + fast_exp(v1[j])); } }
                    u32x4 w; w.x = pk2(v0[0], v0[1]); w.y = pk2(v0[2], v0[3]); w.z = pk2(v1[0], v1[1]); w.w = pk2(v1[2], v1[3]);
                    *(u32x4*)(rowp + bj * HALF) = w; } }
    }
};
struct EpiBf16Res {
    static constexpr bool PERM = true;
    bf16_t* O; const float* R; int ldc;
    DI void operator()(const f32x4 (&acc)[2][2][4][2], const Unit& u, int wr, int wc, int fr, int fq) const {
        const int row0 = u.pm * BM + wr * 64 + fr; const int col0 = u.pn * BM + wc * 32 + 8 * fq;
#pragma unroll
        for (int ai = 0; ai < 2; ++ai)
#pragma unroll
            for (int m = 0; m < 4; ++m) { const size_t ro = (size_t)(row0 + ai * HALF + m * 16) * ldc + col0;
#pragma unroll
                for (int bj = 0; bj < 2; ++bj) { const f32x4 r0 = __builtin_nontemporal_load((const f32x4*)(R + ro + bj * HALF)), r1 = __builtin_nontemporal_load((const f32x4*)(R + ro + bj * HALF + 4));
                    const f32x4 v0 = acc[ai][bj][m][0] + r0, v1 = acc[ai][bj][m][1] + r1;
                    u32x4 w; w.x = pk2(v0[0], v0[1]); w.y = pk2(v0[2], v0[3]); w.z = pk2(v1[0], v1[1]); w.w = pk2(v1[2], v1[3]);
                    *(u32x4*)(O + ro + bj * HALF) = w; } }
    }
};
struct EpiF32Res {
    static constexpr bool PERM = false;
    float* C; const float* R; int ldc; bf16_t* Hb;
    DI void operator()(const f32x4 (&acc)[2][2][4][2], const Unit& u, int wr, int wc, int fr, int fq) const {
        const int row0 = u.pm * BM + wr * 64 + fr, col0 = u.pn * BM + wc * 32 + 4 * fq;
#pragma unroll
        for (int ai = 0; ai < 2; ++ai)
#pragma unroll
            for (int m = 0; m < 4; ++m) { const size_t ro = (size_t)(row0 + ai * HALF + m * 16) * ldc + col0;
#pragma unroll
                for (int bj = 0; bj < 2; ++bj)
#pragma unroll
                    for (int n = 0; n < 2; ++n) { const f32x4 rv = *(const f32x4*)(R + ro + bj * HALF + n * 16); const f32x4 hv = acc[ai][bj][m][n] + rv; if (C) *(f32x4*)(C + ro + bj * HALF + n * 16) = hv;
                        u32x2 hb; hb.x = pk2(hv[0], hv[1]); hb.y = pk2(hv[2], hv[3]); *(u32x2*)(Hb + ro + bj * HALF + n * 16) = hb; } }
    }
};

template <class Epi, class Sched>
DI void gemm_phase(LAS unsigned char* lds, const Gemm g, const Sched& S, const Epi& E) {
    const int tid = threadIdx.x, wid = __builtin_amdgcn_readfirstlane(tid >> 6), lane = tid & 63, wr = wid >> 2, wc = wid & 3, fr = lane & 15, fq = lane >> 4;
    const int K = g.K, nt = K / BK;
    unsigned voffA[2], voffB[2];
#pragma unroll
    for (int i = 0; i < 2; ++i) { int R, C; stage_rc(tid * 16 + i * 8192, R, C); const int Rb = Epi::PERM ? ((R & ~31) + perm32(R & 31)) : R;
        voffA[i] = (unsigned)(R * K + C) * 2u; voffB[i] = (unsigned)(Rb * K + C) * 2u; }
    const size_t kstep = (size_t)(BK * 2);
    const size_t hstep = (size_t)HALF * K * 2;
    const size_t tstep = 2 * hstep;
    const unsigned ldsw = (unsigned)wid * 1024u;
    const int aoff = lds_byte(wr * 64 + fr, fq * 8), boff = lds_byte(wc * 32 + fr, fq * 8);
#define PG8_SA(b, h) (((b) * 2 + (h)) * HTB)
#define PG8_SB(b, h) ((4 + (b) * 2 + (h)) * HTB)
#define PG8_STAGE(bufoff, gbase, voff) do { _Pragma("unroll") for (int _i = 0; _i < 2; ++_i) \
        __builtin_amdgcn_global_load_lds((const unsigned*)((const char*)(gbase) + (voff)[_i]), (LAS unsigned*)(lds + (bufoff) + ldsw + _i * 8192), 16, 0, 0); } while (0)
#define PG8_LDA(dst, b, h) do { _Pragma("unroll") for (int m = 0; m < 4; ++m) _Pragma("unroll") for (int k = 0; k < 2; ++k) dst[m][k] = *(const LAS bf16x8*)(lds + PG8_SA(b, h) + aoff + m * 2048 + k * 1024); } while (0)
#define PG8_LDB(dst, b, h) do { _Pragma("unroll") for (int n = 0; n < 2; ++n) _Pragma("unroll") for (int k = 0; k < 2; ++k) dst[n][k] = *(const LAS bf16x8*)(lds + PG8_SB(b, h) + boff + n * 2048 + k * 1024); } while (0)
#define PG8_MMA(ai, bj, At, Bt) do { __builtin_amdgcn_s_setprio(1); _Pragma("unroll") for (int m = 0; m < 4; ++m) _Pragma("unroll") for (int n = 0; n < 2; ++n) _Pragma("unroll") for (int k = 0; k < 2; ++k) \
        acc[ai][bj][m][n] = __builtin_amdgcn_mfma_f32_16x16x32_bf16(Bt[n][k], At[m][k], acc[ai][bj][m][n], 0, 0, 0); __builtin_amdgcn_s_setprio(0); } while (0)
#define PG8_WAIT_V(n) asm volatile("s_waitcnt vmcnt(" #n ")" ::: "memory")
#define PG8_WAIT_L(n) asm volatile("s_waitcnt lgkmcnt(" #n ")" ::: "memory")
#define PG8_BAR __builtin_amdgcn_s_barrier()
#define PG8_SCHED __builtin_amdgcn_sched_barrier(0)
    Unit cur, nxt; int ui = 0;
    if (!S.next(0, cur)) return;
    f32x4 acc[2][2][4][2];
#pragma unroll
    for (int a = 0; a < 2; ++a)
#pragma unroll
        for (int b = 0; b < 2; ++b)
#pragma unroll
            for (int m = 0; m < 4; ++m)
#pragma unroll
                for (int n = 0; n < 2; ++n) acc[a][b][m][n] = (f32x4){0.f, 0.f, 0.f, 0.f};
    bf16x8 At[4][2], B0[2][2], B1[2][2];
    const char* cA = (const char*)g.A + (size_t)cur.pm * tstep; const char* cB = (const char*)g.Bt + (size_t)cur.pn * tstep;
    PG8_STAGE(PG8_SB(0, 0), cB, voffB); PG8_STAGE(PG8_SA(0, 0), cA, voffA); PG8_STAGE(PG8_SB(0, 1), cB + hstep, voffB); PG8_STAGE(PG8_SA(0, 1), cA + hstep, voffA);
    if (wr == 1) PG8_BAR;
    PG8_WAIT_V(4); PG8_BAR;
    PG8_STAGE(PG8_SB(1, 0), cB + kstep, voffB); PG8_STAGE(PG8_SA(1, 0), cA + kstep, voffA); PG8_STAGE(PG8_SB(1, 1), cB + hstep + kstep, voffB);
    PG8_WAIT_V(6); PG8_BAR;
    for (;;) {
        const bool has_next = S.next(ui + 1, nxt);
        const char* nA = has_next ? (const char*)g.A + (size_t)nxt.pm * tstep : cA; const char* nB = has_next ? (const char*)g.Bt + (size_t)nxt.pn * tstep : cB;
        for (int t = 0; t < nt; t += 2) {
            const bool last = (t == nt - 2);
            const char* a1 = cA + (size_t)(t + 1) * kstep;
            const char* a2 = last ? nA : cA + (size_t)(t + 2) * kstep; const char* b2 = last ? nB : cB + (size_t)(t + 2) * kstep;
            const char* a3 = a2 + kstep; const char* b3 = b2 + kstep;
            PG8_LDB(B0, 0, 0); PG8_SCHED; PG8_LDA(At, 0, 0); PG8_STAGE(PG8_SA(1, 1), a1 + hstep, voffA);
            PG8_WAIT_L(8); PG8_BAR; PG8_WAIT_L(0); PG8_MMA(0, 0, At, B0); PG8_BAR; PG8_SCHED;
            PG8_LDB(B1, 0, 1); PG8_STAGE(PG8_SB(0, 0), b2, voffB);
            PG8_BAR; PG8_WAIT_L(0); PG8_MMA(0, 1, At, B1); PG8_BAR;
            PG8_LDA(At, 0, 1); PG8_STAGE(PG8_SA(0, 0), a2, voffA);
            PG8_BAR; PG8_WAIT_L(0); PG8_MMA(1, 0, At, B0); PG8_BAR; PG8_SCHED;
            PG8_STAGE(PG8_SB(0, 1), b2 + hstep, voffB);
            PG8_WAIT_V(6); PG8_BAR; PG8_MMA(1, 1, At, B1); PG8_BAR;
            PG8_LDB(B0, 1, 0); PG8_SCHED; PG8_LDA(At, 1, 0); PG8_STAGE(PG8_SA(0, 1), a2 + hstep, voffA);
            PG8_WAIT_L(8); PG8_BAR; PG8_WAIT_L(0); PG8_MMA(0, 0, At, B0); PG8_BAR; PG8_SCHED;
            PG8_LDB(B1, 1, 1); PG8_STAGE(PG8_SB(1, 0), b3, voffB);
            PG8_BAR; PG8_WAIT_L(0); PG8_MMA(0, 1, At, B1); PG8_BAR;
            PG8_LDA(At, 1, 1); PG8_STAGE(PG8_SA(1, 0), a3, voffA);
            PG8_BAR; PG8_WAIT_L(0); PG8_MMA(1, 0, At, B0); PG8_BAR; PG8_SCHED;
            PG8_STAGE(PG8_SB(1, 1), b3 + hstep, voffB);
            PG8_WAIT_V(6); PG8_BAR; PG8_MMA(1, 1, At, B1); PG8_BAR;
        }
        E(acc, cur, wr, wc, fr, fq);
        if (!has_next) break;
#pragma unroll
        for (int a = 0; a < 2; ++a)
#pragma unroll
            for (int b = 0; b < 2; ++b)
#pragma unroll
                for (int m = 0; m < 4; ++m)
#pragma unroll
                    for (int n = 0; n < 2; ++n) acc[a][b][m][n] = (f32x4){0.f, 0.f, 0.f, 0.f};
        cur = nxt; cA = nA; cB = nB; ++ui;
    }
    PG8_WAIT_V(0);
    if (wr == 0) PG8_BAR;
    PG8_BAR;
#undef PG8_SA
#undef PG8_SB
#undef PG8_STAGE
#undef PG8_LDA
#undef PG8_LDB
#undef PG8_MMA
#undef PG8_WAIT_V
#undef PG8_WAIT_L
#undef PG8_BAR
#undef PG8_SCHED
}
}

DI void rms_row(const float* src, const float* g, bf16_t* dst, int lane) {
    f32x4 v[8]; float ss = 0.f;
#pragma unroll
    for (int i = 0; i < 4; ++i) { v[2 * i] = *(const f32x4*)(src + 512 * i + 8 * lane); v[2 * i + 1] = *(const f32x4*)(src + 512 * i + 8 * lane + 4); }
#pragma unroll
    for (int i = 0; i < 8; ++i) ss += v[i][0] * v[i][0] + v[i][1] * v[i][1] + v[i][2] * v[i][2] + v[i][3] * v[i][3];
#pragma unroll
    for (int m = 1; m < 64; m <<= 1) ss += shx(ss, m);
    const float rs = __builtin_amdgcn_rsqf(ss * (1.f / 2048.f) + RMS_EPS);
#pragma unroll
    for (int i = 0; i < 4; ++i) {
        const f32x4 g0 = *(const f32x4*)(g + 512 * i + 8 * lane), g1 = *(const f32x4*)(g + 512 * i + 8 * lane + 4);
        const f32x4 a = v[2 * i] * rs * g0, b = v[2 * i + 1] * rs * g1;
        u32x4 w; w.x = pk2(a[0], a[1]); w.y = pk2(a[2], a[3]); w.z = pk2(b[0], b[1]); w.w = pk2(b[2], b[3]);
        *(u32x4*)(dst + 512 * i + 8 * lane) = w;
    }
}

DI void phase0(const Params& p, unsigned char* lds, int bid, int nb, const int part) {
    const int tid = threadIdx.x, lane = tid & 63, wid = tid >> 6;
    float* tile = (float*)lds;
    constexpr int U_IN = 32 * 22, U_SQ = 32 * 8;
    for (int u = bid + (part ? U_IN : 0); u < (part ? U_IN + 2 * U_SQ : U_IN); u += nb) {
        const float* W; bf16_t* Wt; int N; int uu = u;
        if (uu < U_IN) { W = p.w_in; Wt = (bf16_t*)(p.ws + OFF_WINT); N = INC; }
        else if (uu < U_IN + U_SQ) { uu -= U_IN; W = p.w_out; Wt = (bf16_t*)(p.ws + OFF_WOUTT); N = D; }
        else { uu -= U_IN + U_SQ; W = p.peer_wq; Wt = (bf16_t*)(p.ws + OFF_WQT); N = D; }
        const bool foldg = (u >= U_IN + U_SQ);
        const int ntl = N / 256; const int k0 = (uu / ntl) * 64, n0 = (uu % ntl) * 256;
        f32x4 tv[8];
#pragma unroll
        for (int i = 0; i < 8; ++i) tv[i] = *(const f32x4*)(W + (size_t)(k0 + (tid >> 6) + 8 * i) * N + n0 + 4 * (tid & 63));
#pragma unroll
        for (int i = 0; i < 8; ++i) *(f32x4*)(tile + ((tid >> 6) + 8 * i) * 260 + 4 * (tid & 63)) = tv[i];
        __syncthreads();
#pragma unroll
        for (int i = 0; i < 4; ++i) { const int task = tid + 512 * i, n = task >> 3, kc = task & 7; float f[8];
#pragma unroll
            for (int j = 0; j < 8; ++j) { f[j] = tile[(kc * 8 + j) * 260 + n]; if (foldg) f[j] *= p.ln_ffn_g[k0 + kc * 8 + j]; }
            *(bf16x8*)(Wt + (size_t)(n0 + n) * 2048 + k0 + kc * 8) = pack8(f); }
        __syncthreads();
    }
    bf16_t* HN = (bf16_t*)(p.ws + OFF_HN);
    if (part == 0)
    for (int u = bid; u < MROWS / 16; u += nb) {
        const int r0 = (u * 8 + wid) * 2;
        if (r0 >= T + NMETA) { const u32x4 z = {0u, 0u, 0u, 0u};
#pragma unroll
            for (int rr = 0; rr < 2; ++rr)
#pragma unroll
                for (int i = 0; i < 4; ++i) *(u32x4*)(HN + (size_t)(r0 + rr) * D + 512 * i + 8 * lane) = z; }
        else {
            const float* s0 = r0 < T ? p.x + (size_t)r0 * D : p.meta + (size_t)(r0 - T) * D; const float* s1 = s0 + D;
            f32x4 va[8], vb[8];
#pragma unroll
            for (int i = 0; i < 8; ++i) { va[i] = *(const f32x4*)(s0 + 256 * i + 4 * lane); vb[i] = *(const f32x4*)(s1 + 256 * i + 4 * lane); }
            float sa = 0.f, sb = 0.f;
#pragma unroll
            for (int i = 0; i < 8; ++i) { sa += va[i][0] * va[i][0] + va[i][1] * va[i][1] + va[i][2] * va[i][2] + va[i][3] * va[i][3]; sb += vb[i][0] * vb[i][0] + vb[i][1] * vb[i][1] + vb[i][2] * vb[i][2] + vb[i][3] * vb[i][3]; }
#pragma unroll
            for (int m = 1; m < 64; m <<= 1) { sa += shx(sa, m); sb += shx(sb, m); }
            const float ra = __builtin_amdgcn_rsqf(sa * (1.f / 2048.f) + RMS_EPS), rb = __builtin_amdgcn_rsqf(sb * (1.f / 2048.f) + RMS_EPS);
#pragma unroll
            for (int i = 0; i < 8; ++i) {
                const f32x4 g0 = *(const f32x4*)(p.ln_mix_g + 256 * i + 4 * lane);
                { const f32x4 a = va[i] * ra * g0; u32x2 w; w.x = pk2(a[0], a[1]); w.y = pk2(a[2], a[3]); *(u32x2*)(HN + (size_t)r0 * D + 256 * i + 4 * lane) = w; }
                { const f32x4 a = vb[i] * rb * g0; u32x2 w; w.x = pk2(a[0], a[1]); w.y = pk2(a[2], a[3]); *(u32x2*)(HN + (size_t)(r0 + 1) * D + 256 * i + 4 * lane) = w; }
            }
        }
    }
    {
        unsigned char* UBq = p.ws + OFF_UB; unsigned char* VBq = p.ws + OFF_VB; float* SU = (float*)(p.ws + OFF_SU); float* SV = (float*)(p.ws + OFF_SV);
        auto quant_row = [&](f32x4 (&v)[8], const int which, const int e) {
            if (which == 0) {
                float ss = 0.f;
#pragma unroll
                for (int i = 0; i < 8; ++i) ss += v[i][0] * v[i][0] + v[i][1] * v[i][1] + v[i][2] * v[i][2] + v[i][3] * v[i][3];
#pragma unroll
                for (int m = 1; m < 64; m <<= 1) ss += shx(ss, m);
                const float step = 0.335f * __builtin_sqrtf(ss * (1.f / 2048.f)); const float inv = step > 0.f ? 1.f / step : 0.f;
                u32x4 w;
#pragma unroll
                for (int d = 0; d < 4; ++d) { const f32x4 t0 = v[2 * d] * inv + 8.f, t1 = v[2 * d + 1] * inv + 8.f; unsigned pw = 0u;
#pragma unroll
                    for (int j = 0; j < 4; ++j) { const int n0 = (int)fminf(fmaxf(floorf(t0[j]), 0.f), 15.f), n1 = (int)fminf(fmaxf(floorf(t1[j]), 0.f), 15.f); pw |= ((unsigned)n0 | ((unsigned)n1 << 4)) << (8 * j); }
                    w[d] = pw; }
                *(u32x4*)(UBq + (size_t)e * 1024 + 16 * lane) = w;
                if (lane == 0) SU[e] = step;
            } else {
                float am = 0.f;
#pragma unroll
                for (int i = 0; i < 8; ++i) am = fmaxf(fmaxf(fmaxf(am, fabsf(v[i][0])), fmaxf(fabsf(v[i][1]), fabsf(v[i][2]))), fabsf(v[i][3]));
#pragma unroll
                for (int m = 1; m < 64; m <<= 1) am = fmaxf(am, shx(am, m));
                const float sc = am > 0.f ? 6.f / am : 0.f, isc = am * (1.f / 6.f);
                u32x4 w;
#pragma unroll
                for (int d = 0; d < 4; ++d) { const f32x4 t0 = v[2 * d] * sc, t1 = v[2 * d + 1] * sc; unsigned pw = 0u;
                    pw = __builtin_amdgcn_cvt_scalef32_pk_fp4_f32(pw, t0[0], t0[1], 1.0f, 0); pw = __builtin_amdgcn_cvt_scalef32_pk_fp4_f32(pw, t0[2], t0[3], 1.0f, 1);
                    pw = __builtin_amdgcn_cvt_scalef32_pk_fp4_f32(pw, t1[0], t1[1], 1.0f, 2); pw = __builtin_amdgcn_cvt_scalef32_pk_fp4_f32(pw, t1[2], t1[3], 1.0f, 3); w[d] = pw; }
                *(u32x4*)(VBq + (size_t)e * 1024 + 16 * lane) = w;
                if (lane == 0) SV[e] = isc;
            }
        };
        if (part == 1)
        for (int u = bid; u < 2048; u += nb) {
            const int rowi = (u * 8 + wid) * 2; const int which = rowi >> 14, e = rowi & 16383;
            const float* src = (which ? p.peer_v : p.peer_u) + (size_t)e * D + 4 * lane;
            f32x4 va[8], vb[8];
#pragma unroll
            for (int i = 0; i < 8; ++i) { va[i] = *(const f32x4*)(src + 256 * i); vb[i] = *(const f32x4*)(src + D + 256 * i); }
            if (which == 0) {
#pragma unroll
                for (int i = 0; i < 8; ++i) { const f32x4 gg = *(const f32x4*)(p.ln_ffn_g + 4 * lane + 256 * i); va[i] = va[i] * gg; vb[i] = vb[i] * gg; } }
            quant_row(va, which, e); quant_row(vb, which, e + 1);
        }
    }
    if (part == 1)
    for (int u = bid; u < 64; u += nb) {
        const size_t idx = ((size_t)u * 512 + tid) * 8; const float* src = p.sub_keys + idx; bf16_t* dst = (bf16_t*)(p.ws + OFF_SK) + idx;
        const f32x4 a = *(const f32x4*)src, b = *(const f32x4*)(src + 4);
        u32x4 w; w.x = pk2(a[0], a[1]); w.y = pk2(a[2], a[3]); w.z = pk2(b[0], b[1]); w.w = pk2(b[2], b[3]);
        *(u32x4*)dst = w;
    }
    float* ROPE = (float*)(p.ws + OFF_ROPE);
    if (part == 0)
    for (int u = bid; u < 65; u += nb) {
        const int idx = u * 512 + tid;
        if (idx < 2064 * 16) { const int pos = idx >> 4, i = idx & 15;
            const float inv = exp2f(-(float)i * (18.931568569324174f / 16.f));
            const float ang = (float)pos * inv; const float rev = ang * 0.15915494309189535f; const float fr = rev - floorf(rev);
            ROPE[pos * 32 + i] = __builtin_amdgcn_cosf(fr); ROPE[pos * 32 + 16 + i] = __builtin_amdgcn_sinf(fr); }
    }
    float* LB = (float*)(p.ws + OFF_LB);
    if (part == 0)
    for (int u = bid; u < 2; u += nb) { const int k = u * 512 + tid; LB[k] = 1.f / (1.f + __expf(p.lb_logits[1024 + k] - p.lb_logits[k])); }
}

DI void phase_norm2(const Params& p, int bid, int nb) {
    const int lane = threadIdx.x & 63, wid = threadIdx.x >> 6;
    bf16_t* XN = (bf16_t*)(p.ws + OFF_HN);
    for (int u = bid; u < T / 8; u += nb) { const int r = u * 8 + wid; rms_row(p.out + (size_t)r * D, p.ln_ffn_g, XN + (size_t)r * D, lane); }
}

DI void attn_item(const Params& p, unsigned char* lds, int item) {
    const int kvh = item & 1, nbk = (item >> 1) & 15, b = item >> 5;
    const int tid = threadIdx.x, lane = tid & 63, wid = tid >> 6, h5 = lane >> 5, l31 = lane & 31;
    bf16_t* Ks = (bf16_t*)lds;
    bf16_t* Vt = (bf16_t*)(lds + 288 * 272);
    const bf16_t* proj = (const bf16_t*)(p.ws + OFF_PROJ);
    const float* ROPE = (const float*)(p.ws + OFF_ROPE);
    {
        const int sub = tid & 15, rp = tid >> 4;
        float kg[8];
#pragma unroll
        for (int j = 0; j < 8; ++j) kg[j] = p.k_norm_g[sub * 8 + j];
#pragma unroll 1
        for (int pg = 0; pg < 9; pg += 3) {
        u32x4 raws[3];
#pragma unroll
        for (int pass = pg; pass < pg + 3; ++pass) {
            const int slot = pass * 32 + rp; int row = -1;
            if (slot < 16) row = T + slot;
            else if (slot >= 32) { const int s = 128 * (nbk - 1) + (slot - 32); if (s >= 0) row = b * SEQ + s; }
            raws[pass - pg] = (u32x4){0u, 0u, 0u, 0u};
            if (row >= 0) raws[pass - pg] = *(const u32x4*)(proj + (size_t)row * INC + COL_K + kvh * 128 + sub * 8);
        }
#pragma unroll
        for (int pass = pg; pass < pg + 3; ++pass) {
            const int slot = pass * 32 + rp; int row = -1, pos = 0;
            if (slot < 16) { row = T + slot; pos = slot; }
            else if (slot >= 32) { const int s = 128 * (nbk - 1) + (slot - 32); if (s >= 0) { row = b * SEQ + s; pos = NMETA + s; } }
            const u32x4 raw = raws[pass - pg];
            float f[8]; unpack8(raw, f);
            float ss = 0.f;
#pragma unroll
            for (int j = 0; j < 8; ++j) ss += f[j] * f[j];
            ss += shx(ss, 1); ss += shx(ss, 2); ss += shx(ss, 4); ss += shx(ss, 8);
            const float rs = __builtin_amdgcn_rsqf(ss * (1.f / 128.f) + RMS_EPS);
            float pr[8];
#pragma unroll
            for (int j = 0; j < 8; ++j) { f[j] = f[j] * rs * kg[j]; pr[j] = shx(f[j], 2); }
            if (sub < 4 && row >= 0) { const float* cs = ROPE + pos * 32 + (sub & 1) * 8;
#pragma unroll
                for (int j = 0; j < 8; ++j) { const float c = cs[j], s = cs[16 + j]; f[j] = (sub < 2) ? (f[j] * c - pr[j] * s) : (f[j] * c + pr[j] * s); } }
            *(bf16x8*)(Ks + slot * 136 + sub * 8) = pack8(f);
        }
        }
    }
    {
#pragma unroll 1
        for (int ig = 0; ig < 9; ig += 3) {
        u32x4 raws[3];
#pragma unroll
        for (int it = ig; it < ig + 3; ++it) {
            const int idx = it * 512 + tid; const int key = idx % 288, dc = idx / 288; int row = -1;
            if (key < 16) row = T + key;
            else if (key >= 32) { const int s = 128 * (nbk - 1) + (key - 32); if (s >= 0) row = b * SEQ + s; }
            raws[it - ig] = (u32x4){0u, 0u, 0u, 0u};
            if (row >= 0) raws[it - ig] = *(const u32x4*)(proj + (size_t)row * INC + COL_V + kvh * 128 + dc * 8);
        }
#pragma unroll
        for (int it = ig; it < ig + 3; ++it) {
            const int idx = it * 512 + tid; const int key = idx % 288, dc = idx / 288;
            const u32x4 raw = raws[it - ig];
            bf16_t* vp = Vt + (dc * 8) * 292 + key;
            vp[0 * 292] = (bf16_t)(raw.x & 0xffffu); vp[1 * 292] = (bf16_t)(raw.x >> 16); vp[2 * 292] = (bf16_t)(raw.y & 0xffffu); vp[3 * 292] = (bf16_t)(raw.y >> 16);
            vp[4 * 292] = (bf16_t)(raw.z & 0xffffu); vp[5 * 292] = (bf16_t)(raw.z >> 16); vp[6 * 292] = (bf16_t)(raw.w & 0xffffu); vp[7 * 292] = (bf16_t)(raw.w >> 16);
        }
        }
    }
    __syncthreads();
    const int hq = kvh * 4 + (wid >> 1);
    const float sinkv = p.sinks[hq] * LOG2E;
    bf16_t* MIX = (bf16_t*)(p.ws + OFF_MIX);
#pragma unroll 1
    for (int qq = 0; qq < 2; ++qq) {
        const int qt = (wid & 1) * 2 + qq; const int iq = 32 * qt + l31; const int s = 128 * nbk + iq; const size_t row = (size_t)b * SEQ + s;
        bf16x8 qf[8];
        {
            u32x4 raw[8]; float ss = 0.f;
#pragma unroll
            for (int ks = 0; ks < 8; ++ks) { raw[ks] = *(const u32x4*)(proj + row * INC + hq * 128 + 16 * ks + 8 * h5); float f[8]; unpack8(raw[ks], f);
#pragma unroll
                for (int j = 0; j < 8; ++j) ss += f[j] * f[j]; }
            ss += shx(ss, 32);
            const float rs = __builtin_amdgcn_rsqf(ss * (1.f / 128.f) + RMS_EPS) * (0.08838834764831845f * LOG2E);
            {
                float f0[8], f1[8]; unpack8(raw[0], f0); unpack8(raw[1], f1);
                const float* cs = ROPE + (NMETA + s) * 32 + 8 * h5;
#pragma unroll
                for (int j = 0; j < 8; ++j) { const float c = cs[j], sn = cs[16 + j]; const float x1 = f0[j] * rs * p.q_norm_g[8 * h5 + j], x2 = f1[j] * rs * p.q_norm_g[16 + 8 * h5 + j];
                    f0[j] = x1 * c - x2 * sn; f1[j] = x2 * c + x1 * sn; }
                qf[0] = pack8(f0); qf[1] = pack8(f1);
            }
#pragma unroll
            for (int ks = 2; ks < 8; ++ks) { float f[8]; unpack8(raw[ks], f);
#pragma unroll
                for (int j = 0; j < 8; ++j) f[j] *= rs * p.q_norm_g[16 * ks + 8 * h5 + j];
                qf[ks] = pack8(f); }
        }
        float m = sinkv, l = 1.f;
        f32x16 O[4];
#pragma unroll
        for (int dt = 0; dt < 4; ++dt)
#pragma unroll
            for (int r = 0; r < 16; ++r) O[dt][r] = 0.f;
#pragma unroll 1
        for (int kt = -1; kt < 5; ++kt) {
            const int ktc = qt + kt; int slot0 = 0;
            if (kt >= 0) { if (nbk == 0 && ktc < 4) continue; slot0 = 32 + 32 * ktc; }
            f32x16 S;
#pragma unroll
            for (int r = 0; r < 16; ++r) S[r] = 0.f;
#pragma unroll
            for (int ks = 0; ks < 8; ++ks) { const bf16x8 kf = *(const bf16x8*)(Ks + (slot0 + l31) * 136 + 16 * ks + 8 * h5); S = mfma32(kf, qf[ks], S); }
            float tmax = -1e30f;
#pragma unroll
            for (int r = 0; r < 16; ++r) { const int kr = (r & 3) + 8 * (r >> 2) + 4 * h5; bool valid;
                if (kt < 0) valid = kr < 16; else { const int c = 32 * ktc + kr; valid = (c > iq) && (c <= 128 + iq) && (nbk > 0 || c >= 128); }
                S[r] = valid ? S[r] : -1e30f; tmax = fmaxf(tmax, S[r]); }
            tmax = fmaxf(tmax, shx(tmax, 32));
            const float mn = fmaxf(m, tmax); const float alpha = __builtin_amdgcn_exp2f(m - mn);
            float psum = 0.f;
#pragma unroll
            for (int r = 0; r < 16; ++r) { const float pv = __builtin_amdgcn_exp2f(S[r] - mn); psum += pv; S[r] = pv; }
            psum += shx(psum, 32);
            l = l * alpha + psum; m = mn;
#pragma unroll
            for (int dt = 0; dt < 4; ++dt)
#pragma unroll
                for (int r = 0; r < 16; ++r) O[dt][r] *= alpha;
#pragma unroll
            for (int sx = 0; sx < 2; ++sx) {
                float pf[8];
#pragma unroll
                for (int j = 0; j < 8; ++j) pf[j] = S[8 * sx + j];
                const bf16x8 pfr = pack8(pf);
#pragma unroll
                for (int dt = 0; dt < 4; ++dt) {
                    const bf16_t* vb = Vt + (32 * dt + l31) * 292 + slot0 + 16 * sx + 4 * h5;
                    const s16x4 lo = *(const s16x4*)vb, hi = *(const s16x4*)(vb + 8);
                    bf16x8 vf; vf[0] = lo[0]; vf[1] = lo[1]; vf[2] = lo[2]; vf[3] = lo[3]; vf[4] = hi[0]; vf[5] = hi[1]; vf[6] = hi[2]; vf[7] = hi[3];
                    O[dt] = mfma32(vf, pfr, O[dt]);
                }
            }
        }
        const float inv_l = 1.f / l;
        bf16_t* orow = MIX + row * D + hq * 128;
#pragma unroll
        for (int dt = 0; dt < 4; ++dt)
#pragma unroll
            for (int g4 = 0; g4 < 4; ++g4) { u32x2 w; w.x = pk2(O[dt][4 * g4] * inv_l, O[dt][4 * g4 + 1] * inv_l); w.y = pk2(O[dt][4 * g4 + 2] * inv_l, O[dt][4 * g4 + 3] * inv_l);
                *(u32x2*)(orow + 32 * dt + 8 * g4 + 4 * h5) = w; }
    }
    __syncthreads();
}

DI void lds_barrier() { asm volatile("s_waitcnt lgkmcnt(0)" ::: "memory"); __builtin_amdgcn_s_barrier(); asm volatile("" ::: "memory"); }
DI void hgrn_item(const Params& p, unsigned char* lds, int item) {
    const int h = item & 7, b = item >> 3;
    const int tid = threadIdx.x, lane = tid & 63, wid = tid >> 6, g = lane >> 4, l15 = lane & 15;
    bf16_t* QT = (bf16_t*)lds;
    bf16_t* KT = QT + 64 * 136;
    bf16_t* QB = KT + 64 * 136;
    bf16_t* KDT = QB + 64 * 136;
    bf16_t* VT = KDT + 128 * 72;
    bf16_t* SC = VT + 128 * 72;
    float* OL = (float*)(SC + 64 * 72);
    float* GT = OL + 64 * 132;
    float* BL = GT + 1024;
    const bf16_t* proj = (const bf16_t*)(p.ws + OFF_PROJ);
    bf16_t* MIX = (bf16_t*)(p.ws + OFF_MIX);
    const int kp = tid & 63, tg = tid >> 6;
    const float c1a = 1.f - ((const float*)(p.ws + OFF_LB))[h * 128 + 2 * kp], c1b = 1.f - ((const float*)(p.ws + OFF_LB))[h * 128 + 2 * kp + 1];
    const int vs = tid & 63, vc = tid >> 6;
    const int et = tid >> 3, eseg = tid & 7;
    float* GNL = BL + 128;
    if (tid < 128) GNL[tid] = p.hgrn_norm_g[h * 128 + tid];
    f32x4 S[8];
#pragma unroll
    for (int mt = 0; mt < 8; ++mt) S[mt] = (f32x4){0.f, 0.f, 0.f, 0.f};
    unsigned nq[8], nf[8]; u32x4 nva, nvb, nga, ngb;
    auto prefetch = [&](int c) {
#pragma unroll
        for (int i = 0; i < 8; ++i) { const int t = 8 * tg + i; int row;
            if (c == 0) row = T + max(t - 48, 0); else row = b * SEQ + 64 * (c - 1) + t;
            const bf16_t* pr = proj + (size_t)row * INC + h * 128 + 2 * kp; nf[i] = *(const unsigned*)(pr + COL_HF); nq[i] = *(const unsigned*)(pr + COL_HQ); }
        { int row; if (c == 0) row = T + max(vs - 48, 0); else row = b * SEQ + 64 * (c - 1) + vs;
          const bf16_t* pr = proj + (size_t)row * INC + COL_HI + h * 128 + 16 * vc; nva = *(const u32x4*)pr; nvb = *(const u32x4*)(pr + 8); }
        { const int cc = c > 0 ? c - 1 : 0; const bf16_t* gp = proj + ((size_t)b * SEQ + 64 * cc + et) * INC + COL_HG + h * 128 + 16 * eseg; nga = *(const u32x4*)gp; ngb = *(const u32x4*)(gp + 8); }
    };
    prefetch(0);
    for (int c = 0; c < 33; ++c) {
        unsigned cq[8], cf[8];
#pragma unroll
        for (int i = 0; i < 8; ++i) { cq[i] = nq[i]; cf[i] = nf[i]; }
        const bool vvalid = !(c == 0 && vs < 48); const u32x4 z4 = {0u, 0u, 0u, 0u};
        const u32x4 cva = vvalid ? nva : z4, cvb = vvalid ? nvb : z4, cga = nga, cgb = ngb;
        const bool padchunk = (c == 0);
        if (c < 32) prefetch(c + 1);
        {
            float bl[8][2], qs[8][2], kk[8][2]; float csa = 1.f, csb = 1.f;
#pragma unroll
            for (int i = 0; i < 8; ++i) {
                const int t = 8 * tg + i; const bool valid = !(padchunk && t < 48);
                const float ka = valid ? c1a * bf_lo(cf[i]) : 0.f, kb = valid ? c1b * bf_hi(cf[i]) : 0.f;
                csa *= (1.f - ka); csb *= (1.f - kb); bl[i][0] = csa; bl[i][1] = csb;
                qs[i][0] = valid ? bf_lo(cq[i]) : 0.f; qs[i][1] = valid ? bf_hi(cq[i]) : 0.f; kk[i][0] = ka; kk[i][1] = kb;
            }
            *(f32x2*)(GT + tg * 128 + 2 * kp) = (f32x2){csa, csb};
            {
                bf16_t* vp = VT + (16 * vc) * 72 + vs;
                vp[0 * 72] = (bf16_t)(cva.x & 0xffffu); vp[1 * 72] = (bf16_t)(cva.x >> 16); vp[2 * 72] = (bf16_t)(cva.y & 0xffffu); vp[3 * 72] = (bf16_t)(cva.y >> 16);
                vp[4 * 72] = (bf16_t)(cva.z & 0xffffu); vp[5 * 72] = (bf16_t)(cva.z >> 16); vp[6 * 72] = (bf16_t)(cva.w & 0xffffu); vp[7 * 72] = (bf16_t)(cva.w >> 16);
                vp[8 * 72] = (bf16_t)(cvb.x & 0xffffu); vp[9 * 72] = (bf16_t)(cvb.x >> 16); vp[10 * 72] = (bf16_t)(cvb.y & 0xffffu); vp[11 * 72] = (bf16_t)(cvb.y >> 16);
                vp[12 * 72] = (bf16_t)(cvb.z & 0xffffu); vp[13 * 72] = (bf16_t)(cvb.z >> 16); vp[14 * 72] = (bf16_t)(cvb.w & 0xffffu); vp[15 * 72] = (bf16_t)(cvb.w >> 16);
            }
            lds_barrier();
            f32x2 off = {1.f, 1.f}, er = {1.f, 1.f}, ebr = {1.f, 1.f};
#pragma unroll
            for (int gi = 0; gi < 8; ++gi) { const f32x2 gp = *(const f32x2*)(GT + gi * 128 + 2 * kp);
                if (gi < tg) off = off * gp;
                if (gi < 4) er = er * gp; else ebr = ebr * gp; }
            const f32x2 plast = er * ebr;
            const float iera = fast_rcp(fmaxf(er[0], 1e-30f)), ierb = fast_rcp(fmaxf(er[1], 1e-30f));
            float kda[8], kdb[8];
#pragma unroll
            for (int i = 0; i < 8; ++i) {
                const int t = 8 * tg + i; const float pta = off[0] * bl[i][0], ptb = off[1] * bl[i][1];
                const float eqa = fminf(fmaxf(pta * iera, 1e-30f), 1e30f), eqb = fminf(fmaxf(ptb * ierb, 1e-30f), 1e30f);
                const float eka = fast_rcp(eqa), ekb = fast_rcp(eqb);
                const float kea = kk[i][0] * eka, keb = kk[i][1] * ekb;
                *(unsigned*)(QT + t * 136 + 2 * kp) = pk2(qs[i][0] * eqa, qs[i][1] * eqb);
                *(unsigned*)(KT + t * 136 + 2 * kp) = pk2(kea, keb);
                *(unsigned*)(QB + t * 136 + 2 * kp) = pk2(qs[i][0] * pta, qs[i][1] * ptb);
                kda[i] = kea * ebr[0]; kdb[i] = keb * ebr[1];
            }
            *(bf16x8*)(KDT + (2 * kp) * 72 + 8 * tg) = pack8(kda); *(bf16x8*)(KDT + (2 * kp + 1) * 72 + 8 * tg) = pack8(kdb);
            if (tg == 0) *(f32x2*)(BL + 2 * kp) = plast;
        }
        lds_barrier();
#pragma unroll
        for (int q = 0; q < 2; ++q) {
            const int id = 2 * wid + q, ti = id >> 2, si = id & 3;
            f32x4 acc = {0.f, 0.f, 0.f, 0.f};
            if (si <= ti) {
#pragma unroll
                for (int ks = 0; ks < 4; ++ks) { const bf16x8 a = *(const bf16x8*)(QT + (16 * ti + l15) * 136 + 32 * ks + 8 * g); const bf16x8 bb = *(const bf16x8*)(KT + (16 * si + l15) * 136 + 32 * ks + 8 * g); acc = mfma16(a, bb, acc); }
            }
#pragma unroll
            for (int i = 0; i < 4; ++i) { const int t = 16 * ti + 4 * g + i, s = 16 * si + l15; SC[t * 72 + s] = f2bf((s <= t) ? acc[i] : 0.f); }
        }
        f32x4 oacc[4];
        {
            bf16x8 sb[4];
#pragma unroll
            for (int ks = 0; ks < 4; ++ks) { float f[8];
#pragma unroll
                for (int j = 0; j < 4; ++j) { f[j] = S[2 * ks][j]; f[4 + j] = S[2 * ks + 1][j]; }
                sb[ks] = pack8(f); }
#pragma unroll
            for (int mt = 0; mt < 4; ++mt) {
                f32x4 acc = {0.f, 0.f, 0.f, 0.f};
#pragma unroll
                for (int ks = 0; ks < 4; ++ks) { const bf16_t* qp = QB + (16 * mt + l15) * 136 + 32 * ks + 4 * g; const s16x4 lo = *(const s16x4*)qp, hi = *(const s16x4*)(qp + 16);
                    bf16x8 a; a[0] = lo[0]; a[1] = lo[1]; a[2] = lo[2]; a[3] = lo[3]; a[4] = hi[0]; a[5] = hi[1]; a[6] = hi[2]; a[7] = hi[3];
                    acc = mfma16(a, sb[ks], acc); }
                oacc[mt] = acc;
            }
#pragma unroll
            for (int mt = 0; mt < 8; ++mt) {
                const f32x4 e4 = *(const f32x4*)(BL + 16 * mt + 4 * g);
                S[mt] = S[mt] * e4;
#pragma unroll
                for (int ks = 0; ks < 2; ++ks) { const bf16x8 a = *(const bf16x8*)(KDT + (16 * mt + l15) * 72 + 32 * ks + 8 * g); const bf16x8 bv = *(const bf16x8*)(VT + (16 * wid + l15) * 72 + 32 * ks + 8 * g); S[mt] = mfma16(a, bv, S[mt]); }
            }
        }
        lds_barrier();
#pragma unroll
        for (int mt = 0; mt < 4; ++mt) {
            f32x4 acc = oacc[mt];
#pragma unroll
            for (int ks = 0; ks < 2; ++ks) { const bf16x8 a = *(const bf16x8*)(SC + (16 * mt + l15) * 72 + 32 * ks + 8 * g); const bf16x8 bv = *(const bf16x8*)(VT + (16 * wid + l15) * 72 + 32 * ks + 8 * g); acc = mfma16(a, bv, acc); }
#pragma unroll
            for (int i = 0; i < 4; ++i) OL[(16 * mt + 4 * g + i) * 132 + 16 * wid + l15] = acc[i];
        }
        lds_barrier();
        if (c > 0) {
            const size_t row = (size_t)b * SEQ + 64 * (c - 1) + et;
            float o[16]; float ss = 0.f;
#pragma unroll
            for (int i = 0; i < 4; ++i) { const f32x4 v = *(const f32x4*)(OL + et * 132 + 16 * eseg + 4 * i); o[4 * i] = v[0]; o[4 * i + 1] = v[1]; o[4 * i + 2] = v[2]; o[4 * i + 3] = v[3]; }
#pragma unroll
            for (int i = 0; i < 16; ++i) ss += o[i] * o[i];
            ss += shx(ss, 1); ss += shx(ss, 2); ss += shx(ss, 4);
            const float rs = __builtin_amdgcn_rsqf(ss * (1.f / 128.f) + RMS_EPS);
            float hg[16]; unpack8(cga, hg); unpack8(cgb, hg + 8);
            float gn[16];
#pragma unroll
            for (int i = 0; i < 4; ++i) { const f32x4 v = *(const f32x4*)(GNL + 16 * eseg + 4 * i); gn[4 * i] = v[0]; gn[4 * i + 1] = v[1]; gn[4 * i + 2] = v[2]; gn[4 * i + 3] = v[3]; }
            float outv[16];
#pragma unroll
            for (int i = 0; i < 16; ++i) outv[i] = o[i] * rs * gn[i] * hg[i];
            bf16_t* op = MIX + row * D + 1024 + h * 128 + 16 * eseg;
            *(bf16x8*)op = pack8(outv); *(bf16x8*)(op + 8) = pack8(outv + 8);
        }
    }
}

DI int sortable(float f) { const int b = __float_as_int(f); return b ^ ((b >> 31) & 0x7fffffff); }
DI float unsortable(int k) { return __int_as_float(k ^ ((k >> 31) & 0x7fffffff)); }
#define TOPK_INSERT(top, xval) do { int _x = (xval); _Pragma("unroll") for (int _j = 0; _j < 16; ++_j) { const int _hi = max((top)[_j], _x); _x = min((top)[_j], _x); (top)[_j] = _hi; } } while (0)

DI void cex_desc(int& hi, int& lo) { const int a = max(hi, lo), b = min(hi, lo); hi = a; lo = b; }
DI void bitonic_sort16_desc(int (&a)[16]) {
#pragma unroll
    for (int k = 2; k <= 16; k <<= 1)
#pragma unroll
        for (int j = k >> 1; j > 0; j >>= 1)
#pragma unroll
            for (int i = 0; i < 16; ++i) { const int l = i ^ j; if (l > i) { if ((i & k) == 0) cex_desc(a[i], a[l]); else cex_desc(a[l], a[i]); } }
}
DI void merge_top16(int (&top)[16], const int (&g)[16]) {
#pragma unroll
    for (int i = 0; i < 16; ++i) top[i] = max(top[i], g[15 - i]);
#pragma unroll
    for (int j = 8; j > 0; j >>= 1)
#pragma unroll
        for (int i = 0; i < 16; ++i) { const int l = i ^ j; if (l > i) cex_desc(top[i], top[l]); }
}
DI void peer_unit(const Params& p, unsigned char* lds, int unit, const int mode = 0) {
    const int t0 = unit * 32;
    int* SELI = (int*)lds;
    float* SELG = (float*)(lds + 16384);
    const int tid = threadIdx.x, lane = tid & 63, wid = tid >> 6, h5 = lane >> 5, l31 = lane & 31;
    const bf16_t* pq = (const bf16_t*)(p.ws + OFF_PROJ);
    const bf16_t* skb = (const bf16_t*)(p.ws + OFF_SK);
    const bf16_t* XN = (const bf16_t*)(p.ws + OFF_HN);
    const bf16_t* UB = (const bf16_t*)(p.ws + OFF_UB);
    const bf16_t* VB = (const bf16_t*)(p.ws + OFF_VB);
    float* RSL = (float*)(lds + 32768);
    if (mode != 2) {
    for (int q = 0; q < 4; ++q) {
        const int tl = 4 * wid + q; const bf16_t* xp = XN + ((size_t)t0 + tl) * D + 16 * lane; float ss = 0.f;
#pragma unroll
        for (int r = 0; r < 2; ++r) { float f[16]; unpack8(*(const u32x4*)(xp + 1024 * r), f); unpack8(*(const u32x4*)(xp + 1024 * r + 8), f + 8);
#pragma unroll
            for (int i = 0; i < 16; ++i) ss += f[i] * f[i]; }
#pragma unroll
        for (int m = 1; m < 64; m <<= 1) ss += shx(ss, m);
        if (lane == 0) RSL[tl] = __builtin_amdgcn_rsqf(ss * (1.f / 2048.f) + RMS_EPS);
    }
    __syncthreads();
    {
        const int hd = wid; const size_t tok = (size_t)t0 + l31; const float rstok = RSL[l31];
        int top0[16], top1[16];
#pragma unroll
        for (int c = 0; c < 2; ++c) {
            int top[16];
#pragma unroll
            for (int j = 0; j < 16; ++j) top[j] = (int)0x80000000;
            bf16x8 qf[8];
#pragma unroll
            for (int ks = 0; ks < 8; ++ks) qf[ks] = *(const bf16x8*)(pq + tok * D + (hd * 2 + c) * 128 + 16 * ks + 8 * h5);
            bf16x8 kf[8];
#pragma unroll
            for (int ks = 0; ks < 8; ++ks) kf[ks] = *(const bf16x8*)(skb + (size_t)((hd * 2 + c) * 128 + l31) * 128 + 16 * ks + 8 * h5);
#pragma unroll 1
            for (int mt = 0; mt < 4; ++mt) {
                bf16x8 kn[8]; const int mn = mt < 3 ? mt + 1 : mt;
#pragma unroll
                for (int ks = 0; ks < 8; ++ks) kn[ks] = *(const bf16x8*)(skb + (size_t)((hd * 2 + c) * 128 + 32 * mn + l31) * 128 + 16 * ks + 8 * h5);
                f32x16 acc;
#pragma unroll
                for (int r = 0; r < 16; ++r) acc[r] = 0.f;
#pragma unroll
                for (int ks = 0; ks < 8; ++ks) acc = mfma32(kf[ks], qf[ks], acc);
#pragma unroll
                for (int ks = 0; ks < 8; ++ks) kf[ks] = kn[ks];
                int grp[16];
#pragma unroll
                for (int r = 0; r < 16; ++r) { const int n = 32 * mt + (r & 3) + 8 * (r >> 2) + 4 * h5; grp[r] = (sortable(acc[r]) & ~127) | n; }
                bitonic_sort16_desc(grp); merge_top16(top, grp);
            }
            int other[16];
#pragma unroll
            for (int j = 0; j < 16; ++j) other[j] = shxi(top[j], 32);
            merge_top16(top, other);
#pragma unroll
            for (int j = 0; j < 16; ++j) { if (c == 0) top0[j] = top[j]; else top1[j] = top[j]; }
        }
        float v1[16], v2[16];
#pragma unroll
        for (int j = 0; j < 16; ++j) { v1[j] = unsortable(top0[j] & ~127); v2[j] = unsortable(top1[j] & ~127); }
        int c0[16], c1[16], c2[16], c3[16];
#pragma unroll
        for (int j = 0; j < 16; ++j) { c3[j] = (int)0x80000000; }
#pragma unroll
        for (int i = 0; i < 16; ++i)
#pragma unroll
            for (int j = 0; j < 16; ++j)
                if ((i + 1) * (j + 1) <= 16) {
                    int idx = j;
#pragma unroll
                    for (int a = 0; a < 16; ++a) if (a < i) idx += 16 / (a + 1);
                    const float val = v1[i] + v2[j]; const int key = (sortable(val) & ~255) | (i << 4) | j;
                    if (idx < 16) c0[idx] = key; else if (idx < 32) c1[idx - 16] = key; else if (idx < 48) c2[idx - 32] = key; else c3[idx - 48] = key;
                }
        bitonic_sort16_desc(c0); bitonic_sort16_desc(c1); bitonic_sort16_desc(c2); bitonic_sort16_desc(c3);
        merge_top16(c0, c1); merge_top16(c2, c3); merge_top16(c0, c2);
        int best[16];
#pragma unroll
        for (int j = 0; j < 16; ++j) best[j] = c0[j];
        unsigned char* IDXB = lds + 34816 + wid * 2048; unsigned* IDXW = (unsigned*)IDXB;
#pragma unroll
        for (int jq = 0; jq < 4; ++jq) {
            IDXW[jq * 64 + lane] = (unsigned)(top0[4 * jq] & 127) | ((unsigned)(top0[4 * jq + 1] & 127) << 8) | ((unsigned)(top0[4 * jq + 2] & 127) << 16) | ((unsigned)(top0[4 * jq + 3] & 127) << 24);
            IDXW[(4 + jq) * 64 + lane] = (unsigned)(top1[4 * jq] & 127) | ((unsigned)(top1[4 * jq + 1] & 127) << 8) | ((unsigned)(top1[4 * jq + 2] & 127) << 16) | ((unsigned)(top1[4 * jq + 3] & 127) << 24);
        }
        const float mval = unsortable(best[0] & ~255);
        float ev[16]; int ei[16]; float sum = 0.f;
#pragma unroll
        for (int kx = 0; kx < 16; ++kx) {
            const int ij = best[kx] & 255, i = ij >> 4, j = ij & 15;
            const int n1 = IDXB[((i >> 2) * 64 + lane) * 4 + (i & 3)], n2 = IDXB[((4 + (j >> 2)) * 64 + lane) * 4 + (j & 3)];
            ei[kx] = n1 * 128 + n2; ev[kx] = fast_exp((unsortable(best[kx] & ~255) - mval) * rstok); sum += ev[kx];
        }
        const float rsum = 1.f / sum;
        if (lane < 32) {
#pragma unroll
            for (int kx = 0; kx < 16; ++kx) { SELI[l31 * 128 + hd * 16 + kx] = ei[kx]; SELG[l31 * 128 + hd * 16 + kx] = ev[kx] * rsum; }
        }
    }
    }
    __syncthreads();
    if (mode != 1) {
    const unsigned char* UBq = p.ws + OFF_UB; const unsigned char* VBq = p.ws + OFF_VB; const float* SU = (const float*)(p.ws + OFF_SU); const float* SV = (const float*)(p.ws + OFF_SV);
    for (int q = 0; q < 4; ++q) {
        const int tl = 4 * wid + q; const size_t tok = (size_t)t0 + tl;
        unsigned xq[8]; float sx; float sumx;
        {
            float xf[32];
            const bf16_t* xp = XN + tok * D + 4 * lane;
#pragma unroll
            for (int i = 0; i < 8; ++i) { const u32x2 w = *(const u32x2*)(xp + 256 * i); xf[4 * i] = bf_lo(w.x); xf[4 * i + 1] = bf_hi(w.x); xf[4 * i + 2] = bf_lo(w.y); xf[4 * i + 3] = bf_hi(w.y); }
            float am = 0.f;
#pragma unroll
            for (int i = 0; i < 32; ++i) am = fmaxf(am, fabsf(xf[i]));
#pragma unroll
            for (int m = 1; m < 64; m <<= 1) am = fmaxf(am, shx(am, m));
            const float inv = am > 0.f ? 127.f / am : 0.f; sx = am * (1.f / 127.f);
            int isum = 0;
#pragma unroll
            for (int i = 0; i < 8; ++i) { const float* f = xf + 4 * i;
                const int q0 = (int)rintf(f[0] * inv), q1 = (int)rintf(f[1] * inv), q2 = (int)rintf(f[2] * inv), q3 = (int)rintf(f[3] * inv); isum += q0 + q1 + q2 + q3;
                xq[i] = (unsigned)(q0 & 0xff) | ((unsigned)(q1 & 0xff) << 8) | ((unsigned)(q2 & 0xff) << 16) | ((unsigned)(q3 & 0xff) << 24); }
            sumx = (float)isum;
#pragma unroll
            for (int m = 1; m < 64; m <<= 1) sumx += shx(sumx, m);
        }
        const int e_lo = SELI[tl * 128 + lane], e_hi = SELI[tl * 128 + 64 + lane];
        const float g_lo = SELG[tl * 128 + lane], g_hi = SELG[tl * 128 + 64 + lane];
        const float sxr = sx * RSL[tl];
        const float su_lo = SU[e_lo] * sxr, su_hi = SU[e_hi] * sxr, sv_lo = SV[e_lo], sv_hi = SV[e_hi];
        float a_lo = 0.f, a_hi = 0.f;
        u32x4 B0[8], B1[8];
        auto loadRows = [&](u32x4 (&buf)[8], const unsigned char* tab, int j) {
            const int esrc = j < 8 ? e_lo : e_hi;
#pragma unroll
            for (int i = 0; i < 8; ++i) { const int eid = __builtin_amdgcn_readlane(esrc, (j & 7) * 8 + i); buf[i] = *(const u32x4*)(tab + (size_t)eid * 1024 + 16 * lane); }
        };
        auto procU = [&](const u32x4 (&buf)[8], int j) {
            float ps[8];
#pragma unroll
            for (int i = 0; i < 8; ++i) { const u32x4 uu = buf[i]; int acc = 0;
#pragma unroll
                for (int d = 0; d < 4; ++d) { const unsigned wv = uu[d];
                    acc = __builtin_amdgcn_sdot4((int)(wv & 0x0f0f0f0fu), (int)xq[2 * d], acc, false); acc = __builtin_amdgcn_sdot4((int)((wv >> 4) & 0x0f0f0f0fu), (int)xq[2 * d + 1], acc, false); }
                ps[i] = (float)acc; }
            float q1[4], q2[2];
#pragma unroll
            for (int i = 0; i < 4; ++i) { const bool o = lane & 1; const float keep = o ? ps[2 * i + 1] : ps[2 * i], send = o ? ps[2 * i] : ps[2 * i + 1]; q1[i] = keep + shx(send, 1); }
#pragma unroll
            for (int i = 0; i < 2; ++i) { const bool o = lane & 2; const float keep = o ? q1[2 * i + 1] : q1[2 * i], send = o ? q1[2 * i] : q1[2 * i + 1]; q2[i] = keep + shx(send, 2); }
            float q3; { const bool o = lane & 4; const float keep = o ? q2[1] : q2[0], send = o ? q2[0] : q2[1]; q3 = keep + shx(send, 4); }
            q3 += shx(q3, 8); q3 += shx(q3, 16); q3 += shx(q3, 32);
            if ((lane >> 3) == (j & 7)) { if (j < 8) a_lo = q3; else a_hi = q3; }
        };
        float hh[2] = {0.f, 0.f};
        loadRows(B0, UBq, 0); loadRows(B1, UBq, 1);
#pragma unroll 1
        for (int jj = 0; jj < 16; jj += 2) {
            procU(B0, jj);     if (jj + 2 < 16) loadRows(B0, UBq, jj + 2);
            procU(B1, jj + 1); if (jj + 3 < 16) loadRows(B1, UBq, jj + 3);
        }
        a_lo -= 7.5f * sumx; a_hi -= 7.5f * sumx;
        {
            const float av[2] = {a_lo * su_lo, a_hi * su_hi}; const float gv[2] = {g_lo * sv_lo, g_hi * sv_hi};
#pragma unroll
            for (int i = 0; i < 2; ++i) { const float a = av[i]; const float y = 0.7978845608028654f * (a + 0.044715f * a * a * a);
                const float th = 1.f - 2.f * fast_rcp(1.f + fast_exp(2.f * y)); hh[i] = 0.5f * a * (1.f + th) * gv[i]; }
        }
        {
            float* HE = (float*)(p.ws + OFF_HE) + tok * 128; int* EI = (int*)(p.ws + OFF_EI) + tok * 128;
            HE[lane] = hh[0]; HE[64 + lane] = hh[1]; EI[lane] = e_lo; EI[64 + lane] = e_hi;
        }
    }
    }
    __syncthreads();
}


DI void peer_unit_B(const Params& p, int unit) {
    const int t0 = unit * 32; const int tid = threadIdx.x, lane = tid & 63, wid = tid >> 6;
    const bf16_t* XN = (const bf16_t*)(p.ws + OFF_HN); const unsigned char* VBq = p.ws + OFF_VB;
    const float* HEb = (const float*)(p.ws + OFF_HE); const int* EIb = (const int*)(p.ws + OFF_EI);
    int e_lo = EIb[((size_t)t0 + 4 * wid) * 128 + lane], e_hi = EIb[((size_t)t0 + 4 * wid) * 128 + 64 + lane];
    float h_lo = HEb[((size_t)t0 + 4 * wid) * 128 + lane], h_hi = HEb[((size_t)t0 + 4 * wid) * 128 + 64 + lane];
    u32x4 B0[8], B1[8], B2[8];
    auto loadRows = [&](u32x4 (&buf)[8], int j, int elo, int ehi) {
        const int esrc = j < 8 ? elo : ehi;
#pragma unroll
        for (int i = 0; i < 8; ++i) { const int eid = __builtin_amdgcn_readlane(esrc, (j & 7) * 8 + i); buf[i] = *(const u32x4*)(VBq + (size_t)eid * 1024 + 16 * lane); }
    };
    loadRows(B0, 0, e_lo, e_hi); loadRows(B1, 1, e_lo, e_hi); loadRows(B2, 2, e_lo, e_hi);
    for (int q = 0; q < 4; ++q) {
        const size_t tok = (size_t)t0 + 4 * wid + q; const size_t tn = (q < 3) ? tok + 1 : tok;
        const int ne_lo = EIb[tn * 128 + lane], ne_hi = EIb[tn * 128 + 64 + lane]; const float nh_lo = HEb[tn * 128 + lane], nh_hi = HEb[tn * 128 + 64 + lane];
        f32x2 acc[16];
#pragma unroll
        for (int i = 0; i < 16; ++i) acc[i] = (f32x2){0.f, 0.f};
        auto procV = [&](const u32x4 (&buf)[8], int j) {
            const float hsrc = j < 8 ? h_lo : h_hi;
#pragma unroll
            for (int i = 0; i < 8; ++i) {
                const float hv = __int_as_float(__builtin_amdgcn_readlane(__float_as_int(hsrc), (j & 7) * 8 + i));
                const f32x2 hv2 = {hv, hv}; const u32x4 vv = buf[i];
#pragma unroll
                for (int d = 0; d < 4; ++d) { const unsigned wv = vv[d];
                    acc[4 * d + 0] += hv2 * __builtin_amdgcn_cvt_scalef32_pk_f32_fp4(wv, 1.0f, 0); acc[4 * d + 1] += hv2 * __builtin_amdgcn_cvt_scalef32_pk_f32_fp4(wv, 1.0f, 1);
                    acc[4 * d + 2] += hv2 * __builtin_amdgcn_cvt_scalef32_pk_f32_fp4(wv, 1.0f, 2); acc[4 * d + 3] += hv2 * __builtin_amdgcn_cvt_scalef32_pk_f32_fp4(wv, 1.0f, 3); }
            }
        };
#pragma unroll 1
        for (int jj = 0; jj < 15; jj += 3) {
            procV(B0, jj);     if (jj + 3 < 16) loadRows(B0, jj + 3, e_lo, e_hi);
            procV(B1, jj + 1); if (jj + 4 < 16) loadRows(B1, jj + 4, e_lo, e_hi); else if (q < 3) loadRows(B1, 1, ne_lo, ne_hi);
            procV(B2, jj + 2); if (jj + 5 < 16) loadRows(B2, jj + 5, e_lo, e_hi); else if (q < 3) loadRows(B2, 2, ne_lo, ne_hi);
        }
        procV(B0, 15); if (q < 3) loadRows(B0, 0, ne_lo, ne_hi);
        float* orow = p.out + tok * D + 4 * lane; const bf16_t* hrow = XN + tok * D + 4 * lane;
#pragma unroll
        for (int i = 0; i < 8; ++i) { const u32x2 hw = *(const u32x2*)(hrow + 256 * i); f32x4 a;
            a[0] = bf_lo(hw.x) + acc[2 * i][0]; a[1] = bf_hi(hw.x) + acc[2 * i][1]; a[2] = bf_lo(hw.y) + acc[2 * i + 1][0]; a[3] = bf_hi(hw.y) + acc[2 * i + 1][1];
            __builtin_nontemporal_store(a, (f32x4*)(orow + 256 * i)); }
        e_lo = ne_lo; e_hi = ne_hi; h_lo = nh_lo; h_hi = nh_hi;
    }
}

#define XB_TMO      128
#define XB_XCNT(j)  (256  + 64 * (j))
#define XB_XSUB(j)  (1280 + 64 * (j))
#define XB_XGEN(j)  (2304 + 64 * (j))
#define XB_TOP      3328
#define XB_TOPGEN   3392
#define XCD_BAR_WORDS 3456
#define XB_SPIN_CAP (1u << 20)
DI unsigned xb_ld(unsigned* p)              { return __hip_atomic_load(p, __ATOMIC_RELAXED, __HIP_MEMORY_SCOPE_AGENT); }
DI unsigned xb_add(unsigned* p, unsigned v) { return __hip_atomic_fetch_add(p, v, __ATOMIC_RELAXED, __HIP_MEMORY_SCOPE_AGENT); }
DI unsigned xb_xcc_id() { return (unsigned)__builtin_amdgcn_s_getreg((3 << 11) | 20) & 0xFu; }
#define XB_SPIN(cond, bar) do { unsigned _sp = 0; while (cond) { __builtin_amdgcn_s_sleep(1); \
    if ((++_sp & 255u) == 0u) { if (xb_ld(&(bar)[XB_TMO])) break; if (_sp > XB_SPIN_CAP) { atomicAdd(&(bar)[XB_TMO], 1u); break; } } } } while (0)
struct XcdBarrier { unsigned* bar; unsigned x; volatile LAS unsigned* st; };
DI XcdBarrier xcd_barrier_post(unsigned* bar, volatile LAS unsigned* st) {
    XcdBarrier b; b.bar = bar; b.x = xb_xcc_id(); b.st = st;
    if (threadIdx.x == 0) (void)xb_add(&bar[XB_XCNT(b.x)], 1u);
    return b;
}
DI void xcd_barrier_complete(unsigned* bar, unsigned x, unsigned& nloc, unsigned& nx) {
    const unsigned G = gridDim.x * gridDim.y * gridDim.z;
    unsigned sum, cnt, mine, sp = 0u;
    for (;;) {
        sum = 0u; cnt = 0u; mine = 0u;
#pragma unroll
        for (unsigned j = 0; j < 16; ++j) { const unsigned c = xb_ld(&bar[XB_XCNT(j)]); sum += c; cnt += (c > 0u) ? 1u : 0u; mine = (j == x) ? c : mine; }
        if (sum == G) break;
        __builtin_amdgcn_s_sleep(1);
        if ((++sp & 255u) == 0u) { if (xb_ld(&bar[XB_TMO])) break; if (sp > XB_SPIN_CAP) { atomicAdd(&bar[XB_TMO], 1u); break; } }
    }
    nloc = mine > 0u ? mine : 1u; nx = cnt > 0u ? cnt : 1u;
}
DI void xcd_barrier(const XcdBarrier& b) {
    asm volatile("s_waitcnt vmcnt(0)" ::: "memory");
    __syncthreads();
    if (threadIdx.x == 0) {
        unsigned* bar = b.bar;
        __builtin_amdgcn_s_waitcnt(0);
        unsigned nloc = b.st[0], nx = b.st[1];
        if (nloc == 0u) { xcd_barrier_complete(bar, b.x, nloc, nx); b.st[0] = nloc; b.st[1] = nx; }
        const unsigned old = xb_add(&bar[XB_XSUB(b.x)], 1u);
        const unsigned gen = old / nloc;
        if (old + 1u == (gen + 1u) * nloc) {
            __builtin_amdgcn_fence(__ATOMIC_RELEASE, "agent");
            asm volatile("s_waitcnt vmcnt(0)" ::: "memory");
            const unsigned og = xb_add(&bar[XB_TOP], 1u);
            const unsigned tg = og / nx;
            if (og + 1u == (tg + 1u) * nx) xb_add(&bar[XB_TOPGEN], 1u);
            else XB_SPIN(xb_ld(&bar[XB_TOPGEN]) == tg, bar);
            __builtin_amdgcn_fence(__ATOMIC_ACQUIRE, "agent");
            xb_add(&bar[XB_XGEN(b.x)], 1u);
            asm volatile("s_waitcnt vmcnt(0)" ::: "memory");
        } else {
            XB_SPIN(xb_ld(&bar[XB_XGEN(b.x)]) == gen, bar);
            __builtin_amdgcn_fence(__ATOMIC_ACQUIRE, "agent");
            asm volatile("s_waitcnt vmcnt(0)" ::: "memory");
        }
    }
    __syncthreads();
}

template <int MODE>
__global__ __launch_bounds__(512, 2) void fwd_kernel(Params p) {
    extern __shared__ __attribute__((aligned(16))) unsigned char shm[];
    const int bid = blockIdx.x, nb = gridDim.x;
    XcdBarrier xb{};
    if constexpr (MODE < 0) {
        volatile LAS unsigned* st = (volatile LAS unsigned*)((LAS unsigned char*)shm + (DYN_LDS - 16));
        if (threadIdx.x == 0) { st[0] = 0u; st[1] = 0u; }
        __syncthreads();
        xb = xcd_barrier_post((unsigned*)(p.ws + OFF_XBAR), st);
    }
    if constexpr (MODE < 0 || MODE == 0) phase0(p, shm, bid, nb, 0);
    if constexpr (MODE < 0) { if (p.ws == nullptr) cg::this_grid().sync();
        xcd_barrier(xb); }
    if constexpr (MODE < 0 || MODE == 1) {
        pg8::StaticOrder S; S.init(MROWS, INC, nb, bid);
        pg8::EpiBf16 E{(bf16_t*)(p.ws + OFF_PROJ), INC, 1};
        pg8::gemm_phase((LAS unsigned char*)shm, pg8::Gemm{(const bf16_t*)(p.ws + OFF_HN), (const bf16_t*)(p.ws + OFF_WINT), MROWS, INC, D}, S, E);
    }
#if REP == 1
    if constexpr (MODE < 0) { __syncthreads();
        pg8::StaticOrder S; S.init(MROWS, INC, nb, bid);
        pg8::EpiBf16 E{(bf16_t*)(p.ws + OFF_PROJ), INC, 1};
        pg8::gemm_phase((LAS unsigned char*)shm, pg8::Gemm{(const bf16_t*)(p.ws + OFF_HN), (const bf16_t*)(p.ws + OFF_WINT), MROWS, INC, D}, S, E); }
#endif
    if constexpr (MODE < 0) xcd_barrier(xb);
    if constexpr (MODE < 0 || MODE == 2) {
        if (nb >= 128) { if (bid < 64) hgrn_item(p, shm, bid); else { for (int it = bid - 64; it < 256; it += nb - 64) attn_item(p, shm, it); phase0(p, shm, bid - 64, nb - 64, 1); } }
        else { for (int it = bid; it < 64; it += nb) hgrn_item(p, shm, it); for (int it = bid; it < 256; it += nb) attn_item(p, shm, it); phase0(p, shm, bid, nb, 1); }
    }
#if REP == 2
    if constexpr (MODE < 0) { __syncthreads(); if (bid < 64) hgrn_item(p, shm, bid); else for (int it = bid - 64; it < 256; it += nb - 64) attn_item(p, shm, it); }
#endif
    if constexpr (MODE < 0) xcd_barrier(xb);
    if constexpr (MODE < 0 || MODE == 3) {
        pg8::StaticOrder S; S.init(T, D, nb, bid);
        pg8::EpiBf16Res E{(bf16_t*)(p.ws + OFF_HN), p.x, D};
        pg8::gemm_phase((LAS unsigned char*)shm, pg8::Gemm{(const bf16_t*)(p.ws + OFF_MIX), (const bf16_t*)(p.ws + OFF_WOUTT), T, D, D}, S, E);
    }
    if constexpr (MODE < 0) xcd_barrier(xb);
    if constexpr (MODE < 0 || MODE == 5) {
        pg8::StaticOrder S; S.init(T, D, nb, bid);
        pg8::EpiBf16 E{(bf16_t*)(p.ws + OFF_PROJ), D, 0};
        pg8::gemm_phase((LAS unsigned char*)shm, pg8::Gemm{(const bf16_t*)(p.ws + OFF_HN), (const bf16_t*)(p.ws + OFF_WQT), T, D, D}, S, E);
    }
    if constexpr (MODE < 0) xcd_barrier(xb);
#if REP == 6
    if constexpr (MODE < 0) { for (int u = bid; u < T / 32; u += nb) peer_unit(p, shm, u, true); }
#endif
    if constexpr (MODE < 0 || MODE == 6) {
        if (nb == 256 && ((bid >> 3) & 1)) {
            peer_unit(p, shm, bid, 1); peer_unit(p, shm + 51200, bid + nb, 1); peer_unit(p, shm, bid, 2); peer_unit(p, shm + 51200, bid + nb, 2);
        } else { for (int u = bid; u < T / 32; u += nb) peer_unit(p, shm, u); }
    }
    if constexpr (MODE < 0 || MODE == 6) { for (int u = bid; u < T / 32; u += nb) peer_unit_B(p, u); }
}

template <int MODE> static void launch_plain(const Params& p, int grid, hipStream_t stream) {
    hipFuncSetAttribute((const void*)fwd_kernel<MODE>, hipFuncAttributeMaxDynamicSharedMemorySize, DYN_LDS);
    hipLaunchKernelGGL((fwd_kernel<MODE>), dim3(grid), dim3(512), DYN_LDS, stream, p);
}

extern "C" void kernel_launch(void* const* d_in, const int* in_sizes, int n_in, void* d_out, int out_size, void* d_ws, size_t ws_size, hipStream_t stream) {
    if (ws_size < WS_NEED) { fprintf(stderr, "workspace too small: %zu < %zu\n", ws_size, WS_NEED); return; }
    Params p{};
    p.x = (const float*)d_in[0]; p.meta = (const float*)d_in[1]; p.lb_logits = (const float*)d_in[2]; p.ln_mix_g = (const float*)d_in[3]; p.w_in = (const float*)d_in[4];
    p.q_norm_g = (const float*)d_in[5]; p.k_norm_g = (const float*)d_in[6]; p.sinks = (const float*)d_in[7]; p.hgrn_norm_g = (const float*)d_in[8]; p.w_out = (const float*)d_in[9];
    p.ln_ffn_g = (const float*)d_in[10]; p.peer_wq = (const float*)d_in[11]; p.sub_keys = (const float*)d_in[12]; p.peer_u = (const float*)d_in[13]; p.peer_v = (const float*)d_in[14];
    p.out = (float*)d_out; p.ws = (unsigned char*)d_ws;
#if MK_SINGLE
    static int grid_blocks = 0;
    if (!grid_blocks) {
        hipFuncSetAttribute((const void*)fwd_kernel<-1>, hipFuncAttributeMaxDynamicSharedMemorySize, DYN_LDS);
        int dev = 0, cus = 0, per_cu = 0; hipGetDevice(&dev); hipDeviceGetAttribute(&cus, hipDeviceAttributeMultiprocessorCount, dev);
        hipOccupancyMaxActiveBlocksPerMultiprocessor(&per_cu, fwd_kernel<-1>, 512, DYN_LDS);
        if (per_cu > 1) per_cu = 1;
        grid_blocks = cus * per_cu;
    }
    hipMemsetAsync((char*)d_ws + OFF_XBAR, 0, XCD_BAR_WORDS * 4, stream);
    void* args[] = {&p};
    hipError_t e = hipLaunchCooperativeKernel((void*)fwd_kernel<-1>, dim3(grid_blocks), dim3(512), args, DYN_LDS, stream);
    if (e != hipSuccess) fprintf(stderr, "cooperative launch failed: %s (grid %d)\n", hipGetErrorString(e), grid_blocks);
#else
    launch_plain<0>(p, 256, stream); launch_plain<1>(p, 256, stream); launch_plain<2>(p, 256, stream); launch_plain<3>(p, 256, stream);
    launch_plain<4>(p, 256, stream); launch_plain<5>(p, 256, stream); launch_plain<6>(p, 256, stream);
#endif
}
```

```cpp
#include <hip/hip_runtime.h>
#include <hip/hip_cooperative_groups.h>
#include <cstdio>
namespace cg = cooperative_groups;

#ifndef REP
#define REP 0
#endif
#ifndef MK_SINGLE
#define MK_SINGLE 1
#endif

#define LAS __attribute__((address_space(3)))
#define DI __device__ __forceinline__
typedef unsigned short bf16_t;
typedef short bf16x8 __attribute__((ext_vector_type(8)));
typedef short s16x4 __attribute__((ext_vector_type(4)));
typedef float f32x4 __attribute__((ext_vector_type(4)));
typedef float f32x16 __attribute__((ext_vector_type(16)));
typedef unsigned u32x4 __attribute__((ext_vector_type(4)));
typedef unsigned u32x2 __attribute__((ext_vector_type(2)));
typedef __bf16 bf16x2_t __attribute__((ext_vector_type(2)));
typedef float f32x2 __attribute__((ext_vector_type(2)));

constexpr int D = 2048, SEQ = 2048, T = 16384, NMETA = 16, MROWS = 16640, INC = 5632;
constexpr int COL_K = 1024, COL_V = 1280, COL_HQ = 1536, COL_HF = 2560, COL_HI = 3584, COL_HG = 4608;
constexpr float RMS_EPS = 1e-6f;
constexpr float LOG2E = 1.4426950408889634f;

constexpr size_t OFF_WINT = 0;
constexpr size_t OFF_WOUTT = OFF_WINT + (size_t)INC * D * 2;
constexpr size_t OFF_WQT = OFF_WOUTT + (size_t)D * D * 2;
constexpr size_t OFF_HN = OFF_WQT + (size_t)D * D * 2;
constexpr size_t OFF_PROJ = OFF_HN + (size_t)MROWS * D * 2;
constexpr size_t OFF_MIX = OFF_PROJ + (size_t)MROWS * INC * 2;
constexpr size_t OFF_UB = OFF_MIX + (size_t)T * D * 2;
constexpr size_t OFF_VB = OFF_UB + (size_t)16384 * D * 2;
constexpr size_t OFF_SK = OFF_VB + (size_t)16384 * D * 2;
constexpr size_t OFF_ROPE = OFF_SK + (size_t)262144 * 2;
constexpr size_t OFF_LB = OFF_ROPE + (size_t)2064 * 32 * 4;
constexpr size_t OFF_SU = OFF_LB + 4096;
constexpr size_t OFF_SV = OFF_SU + 65536;
constexpr size_t OFF_XBAR = OFF_SV + 65536;
constexpr size_t OFF_HE = OFF_XBAR + 16384;
constexpr size_t OFF_EI = OFF_HE + (size_t)T * 128 * 4;
constexpr size_t WS_NEED = OFF_EI + (size_t)T * 128 * 4;
constexpr int DYN_LDS = 155648;

struct Params {
    const float *x, *meta, *lb_logits, *ln_mix_g, *w_in, *q_norm_g, *k_norm_g, *sinks, *hgrn_norm_g, *w_out, *ln_ffn_g, *peer_wq, *sub_keys, *peer_u, *peer_v;
    float* out;
    unsigned char* ws;
};

DI unsigned pk2(float a, float b) { f32x2 v = {a, b}; bf16x2_t r = __builtin_convertvector(v, bf16x2_t); return __builtin_bit_cast(unsigned, r); }
DI bf16_t f2bf(float a) { return (bf16_t)(pk2(a, 0.f) & 0xffffu); }
DI float bf_lo(unsigned u) { return __uint_as_float(u << 16); }
DI float bf_hi(unsigned u) { return __uint_as_float(u & 0xffff0000u); }
DI float bf2f(bf16_t h) { return __uint_as_float(((unsigned)h) << 16); }
DI float shx(float v, int m) { return __shfl_xor(v, m, 64); }
DI int shxi(int v, int m) { return __shfl_xor(v, m, 64); }
DI float fast_exp(float x) { return __builtin_amdgcn_exp2f(x * LOG2E); }
DI float fast_rcp(float x) { return __builtin_amdgcn_rcpf(x); }
DI float dot2u(unsigned w, unsigned x, float acc) { return __builtin_amdgcn_fdot2_f32_bf16(__builtin_bit_cast(bf16x2_t, w), __builtin_bit_cast(bf16x2_t, x), acc, false); }
DI f32x16 mfma32(bf16x8 a, bf16x8 b, f32x16 c) { return __builtin_amdgcn_mfma_f32_32x32x16_bf16(a, b, c, 0, 0, 0); }
DI f32x4 mfma16(bf16x8 a, bf16x8 b, f32x4 c) { return __builtin_amdgcn_mfma_f32_16x16x32_bf16(a, b, c, 0, 0, 0); }
DI bf16x8 pack8(const float* f) { u32x4 w; w.x = pk2(f[0], f[1]); w.y = pk2(f[2], f[3]); w.z = pk2(f[4], f[5]); w.w = pk2(f[6], f[7]); return __builtin_bit_cast(bf16x8, w); }
DI void unpack8(u32x4 w, float* f) { f[0] = bf_lo(w.x); f[1] = bf_hi(w.x); f[2] = bf_lo(w.y); f[3] = bf_hi(w.y); f[4] = bf_lo(w.z); f[5] = bf_hi(w.z); f[6] = bf_lo(w.w); f[7] = bf_hi(w.w); }

namespace pg8 {
constexpr int BM = 256, BK = 64, HALF = 128, HTB = HALF * BK * 2, STAGE_BYTES = 8 * HTB, NXCD = 8, WGM = 8;
DI int lds_byte(int r, int c) { const int st = (r >> 4) * 2 + (c >> 5), rr = r & 15, cc = c & 31, ob = rr * 64 + cc * 2; return st * 1024 + (ob ^ (((ob >> 9) & 1) << 5)); }
DI void stage_rc(int b, int& R, int& C) { const int st = b / 1024, sb = b % 1024, swz = sb ^ (((sb >> 9) & 1) << 5); R = (st >> 1) * 16 + swz / 64; C = (st & 1) * 32 + (swz % 64) / 2; }
DI int perm32(int rho) { const int n = rho >> 4, i = rho & 15; return 8 * (i >> 2) + 4 * n + (i & 3); }
struct Unit { int pm, pn; };
struct Gemm { const bf16_t* A; const bf16_t* Bt; int M, N, K; };
struct StaticOrder {
    int nM, nN, nwg, G, c;
    DI void init(int M, int N, int G_, int c_) { nM = M / BM; nN = N / BM; nwg = nM * nN; G = G_; c = c_; }
    DI bool next(int i, Unit& u) const {
        const long L = (long)i * G + c; if (L >= nwg) return false;
        int wgid = (int)L; { const int q = nwg / NXCD, r = nwg % NXCD, xcd = wgid % NXCD, off = wgid / NXCD; wgid = (xcd < r ? xcd * (q + 1) : r * (q + 1) + (xcd - r) * q) + off; }
        const int nig = WGM * nN, gid = wgid / nig, fm = gid * WGM, gsz = (nM - fm) < WGM ? (nM - fm) : WGM;
        u.pm = fm + ((wgid % nig) % gsz); u.pn = (wgid % nig) / gsz; return true;
    }
};
struct EpiBf16 {
    static constexpr bool PERM = true;
    bf16_t* O; int ldc; int acts;
    DI void operator()(const f32x4 (&acc)[2][2][4][2], const Unit& u, int wr, int wc, int fr, int fq) const {
        const int row0 = u.pm * BM + wr * 64 + fr; const int col0 = u.pn * BM + wc * 32 + 8 * fq;
        const int kind = !acts ? 0 : (((u.pn >= 6 && u.pn < 10) || u.pn >= 18) ? 1 : ((u.pn >= 10 && u.pn < 14) ? 2 : 0));
#pragma unroll
        for (int ai = 0; ai < 2; ++ai)
#pragma unroll
            for (int m = 0; m < 4; ++m) { bf16_t* rowp = O + (size_t)(row0 + ai * HALF + m * 16) * ldc + col0;
#pragma unroll
                for (int bj = 0; bj < 2; ++bj) { f32x4 v0 = acc[ai][bj][m][0], v1 = acc[ai][bj][m][1];
                    if (kind == 1) {
#pragma unroll
                        for (int j = 0; j < 4; ++j) { v0[j] = v0[j] * fast_rcp(1.f + fast_exp(-v0[j])); v1[j] = v1[j] * fast_rcp(1.f + fast_exp(-v1[j])); } }
                    else if (kind == 2) {
#pragma unroll
                        for (int j = 0; j < 4; ++j) { v0[j] = fast_rcp(1.f + fast_exp(v0[j])); v1[j] = fast_rcp(1.f + fast_exp(v1[j])); } }
                    u32x4 w; w.x = pk2(v0[0], v0[1]); w.y = pk2(v0[2], v0[3]); w.z = pk2(v1[0], v1[1]); w.w = pk2(v1[2], v1[3]);
                    *(u32x4*)(rowp + bj * HALF) = w; } }
    }
};
struct EpiBf16Res {
    static constexpr bool PERM = true;
    bf16_t* O; const float* R; int ldc;
    DI void operator()(const f32x4 (&acc)[2][2][4][2], const Unit& u, int wr, int wc, int fr, int fq) const {
        const int row0 = u.pm * BM + wr * 64 + fr; const int col0 = u.pn * BM + wc * 32 + 8 * fq;
#pragma unroll
        for (int ai = 0; ai < 2; ++ai)
#pragma unroll
            for (int m = 0; m < 4; ++m) { const size_t ro = (size_t)(row0 + ai * HALF + m * 16) * ldc + col0;
#pragma unroll
                for (int bj = 0; bj < 2; ++bj) { const f32x4 r0 = __builtin_nontemporal_load((const f32x4*)(R + ro + bj * HALF)), r1 = __builtin_nontemporal_load((const f32x4*)(R + ro + bj * HALF + 4));
                    const f32x4 v0 = acc[ai][bj][m][0] + r0, v1 = acc[ai][bj][m][1] + r1;
                    u32x4 w; w.x = pk2(v0[0], v0[1]); w.y = pk2(v0[2], v0[3]); w.z = pk2(v1[0], v1[1]); w.w = pk2(v1[2], v1[3]);
                    *(u32x4*)(O + ro + bj * HALF) = w; } }
    }
};
struct EpiF32Res {
    static constexpr bool PERM = false;
    float* C; const float* R; int ldc; bf16_t* Hb;
    DI void operator()(const f32x4 (&acc)[2][2][4][2], const Unit& u, int wr, int wc, int fr, int fq) const {
        const int row0 = u.pm * BM + wr * 64 + fr, col0 = u.pn * BM + wc * 32 + 4 * fq;
#pragma unroll
        for (int ai = 0; ai < 2; ++ai)
#pragma unroll
            for (int m = 0; m < 4; ++m) { const size_t ro = (size_t)(row0 + ai * HALF + m * 16) * ldc + col0;
#pragma unroll
                for (int bj = 0; bj < 2; ++bj)
#pragma unroll
                    for (int n = 0; n < 2; ++n) { const f32x4 rv = *(const f32x4*)(R + ro + bj * HALF + n * 16); const f32x4 hv = acc[ai][bj][m][n] + rv; if (C) *(f32x4*)(C + ro + bj * HALF + n * 16) = hv;
                        u32x2 hb; hb.x = pk2(hv[0], hv[1]); hb.y = pk2(hv[2], hv[3]); *(u32x2*)(Hb + ro + bj * HALF + n * 16) = hb; } }
    }
};

template <class Epi, class Sched>
DI void gemm_phase(LAS unsigned char* lds, const Gemm g, const Sched& S, const Epi& E) {
    const int tid = threadIdx.x, wid = __builtin_amdgcn_readfirstlane(tid >> 6), lane = tid & 63, wr = wid >> 2, wc = wid & 3, fr = lane & 15, fq = lane >> 4;
    const int K = g.K, nt = K / BK;
    unsigned voffA[2], voffB[2];
#pragma unroll
    for (int i = 0; i < 2; ++i) { int R, C; stage_rc(tid * 16 + i * 8192, R, C); const int Rb = Epi::PERM ? ((R & ~31) + perm32(R & 31)) : R;
        voffA[i] = (unsigned)(R * K + C) * 2u; voffB[i] = (unsigned)(Rb * K + C) * 2u; }
    const size_t kstep = (size_t)(BK * 2);
    const size_t hstep = (size_t)HALF * K * 2;
    const size_t tstep = 2 * hstep;
    const unsigned ldsw = (unsigned)wid * 1024u;
    const int aoff = lds_byte(wr * 64 + fr, fq * 8), boff = lds_byte(wc * 32 + fr, fq * 8);
#define PG8_SA(b, h) (((b) * 2 + (h)) * HTB)
#define PG8_SB(b, h) ((4 + (b) * 2 + (h)) * HTB)
#define PG8_STAGE(bufoff, gbase, voff) do { _Pragma("unroll") for (int _i = 0; _i < 2; ++_i) \
        __builtin_amdgcn_global_load_lds((const unsigned*)((const char*)(gbase) + (voff)[_i]), (LAS unsigned*)(lds + (bufoff) + ldsw + _i * 8192), 16, 0, 0); } while (0)
#define PG8_LDA(dst, b, h) do { _Pragma("unroll") for (int m = 0; m < 4; ++m) _Pragma("unroll") for (int k = 0; k < 2; ++k) dst[m][k] = *(const LAS bf16x8*)(lds + PG8_SA(b, h) + aoff + m * 2048 + k * 1024); } while (0)
#define PG8_LDB(dst, b, h) do { _Pragma("unroll") for (int n = 0; n < 2; ++n) _Pragma("unroll") for (int k = 0; k < 2; ++k) dst[n][k] = *(const LAS bf16x8*)(lds + PG8_SB(b, h) + boff + n * 2048 + k * 1024); } while (0)
#define PG8_MMA(ai, bj, At, Bt) do { __builtin_amdgcn_s_setprio(1); _Pragma("unroll") for (int m = 0; m < 4; ++m) _Pragma("unroll") for (int n = 0; n < 2; ++n) _Pragma("unroll") for (int k = 0; k < 2; ++k) \
        acc[ai][bj][m][n] = __builtin_amdgcn_mfma_f32_16x16x32_bf16(Bt[n][k], At[m][k], acc[ai][bj][m][n], 0, 0, 0); __builtin_amdgcn_s_setprio(0); } while (0)
#define PG8_WAIT_V(n) asm volatile("s_waitcnt vmcnt(" #n ")" ::: "memory")
#define PG8_WAIT_L(n) asm volatile("s_waitcnt lgkmcnt(" #n ")" ::: "memory")
#define PG8_BAR __builtin_amdgcn_s_barrier()
#define PG8_SCHED __builtin_amdgcn_sched_barrier(0)
    Unit cur, nxt; int ui = 0;
    if (!S.next(0, cur)) return;
    f32x4 acc[2][2][4][2];
#pragma unroll
    for (int a = 0; a < 2; ++a)
#pragma unroll
        for (int b = 0; b < 2; ++b)
#pragma unroll
            for (int m = 0; m < 4; ++m)
#pragma unroll
                for (int n = 0; n < 2; ++n) acc[a][b][m][n] = (f32x4){0.f, 0.f, 0.f, 0.f};
    bf16x8 At[4][2], B0[2][2], B1[2][2];
    const char* cA = (const char*)g.A + (size_t)cur.pm * tstep; const char* cB = (const char*)g.Bt + (size_t)cur.pn * tstep;
    PG8_STAGE(PG8_SB(0, 0), cB, voffB); PG8_STAGE(PG8_SA(0, 0), cA, voffA); PG8_STAGE(PG8_SB(0, 1), cB + hstep, voffB); PG8_STAGE(PG8_SA(0, 1), cA + hstep, voffA);
    if (wr == 1) PG8_BAR;
    PG8_WAIT_V(4); PG8_BAR;
    PG8_STAGE(PG8_SB(1, 0), cB + kstep, voffB); PG8_STAGE(PG8_SA(1, 0), cA + kstep, voffA); PG8_STAGE(PG8_SB(1, 1), cB + hstep + kstep, voffB);
    PG8_WAIT_V(6); PG8_BAR;
    for (;;) {
        const bool has_next = S.next(ui + 1, nxt);
        const char* nA = has_next ? (const char*)g.A + (size_t)nxt.pm * tstep : cA; const char* nB = has_next ? (const char*)g.Bt + (size_t)nxt.pn * tstep : cB;
        for (int t = 0; t < nt; t += 2) {
            const bool last = (t == nt - 2);
            const char* a1 = cA + (size_t)(t + 1) * kstep;
            const char* a2 = last ? nA : cA + (size_t)(t + 2) * kstep; const char* b2 = last ? nB : cB + (size_t)(t + 2) * kstep;
            const char* a3 = a2 + kstep; const char* b3 = b2 + kstep;
            PG8_LDB(B0, 0, 0); PG8_SCHED; PG8_LDA(At, 0, 0); PG8_STAGE(PG8_SA(1, 1), a1 + hstep, voffA);
            PG8_WAIT_L(8); PG8_BAR; PG8_WAIT_L(0); PG8_MMA(0, 0, At, B0); PG8_BAR; PG8_SCHED;
            PG8_LDB(B1, 0, 1); PG8_STAGE(PG8_SB(0, 0), b2, voffB);
            PG8_BAR; PG8_WAIT_L(0); PG8_MMA(0, 1, At, B1); PG8_BAR;
            PG8_LDA(At, 0, 1); PG8_STAGE(PG8_SA(0, 0), a2, voffA);
            PG8_BAR; PG8_WAIT_L(0); PG8_MMA(1, 0, At, B0); PG8_BAR; PG8_SCHED;
            PG8_STAGE(PG8_SB(0, 1), b2 + hstep, voffB);
            PG8_WAIT_V(6); PG8_BAR; PG8_MMA(1, 1, At, B1); PG8_BAR;
            PG8_LDB(B0, 1, 0); PG8_SCHED; PG8_LDA(At, 1, 0); PG8_STAGE(PG8_SA(0, 1), a2 + hstep, voffA);
            PG8_WAIT_L(8); PG8_BAR; PG8_WAIT_L(0); PG8_MMA(0, 0, At, B0); PG8_BAR; PG8_SCHED;
            PG8_LDB(B1, 1, 1); PG8_STAGE(PG8_SB(1, 0), b3, voffB);
            PG8_BAR; PG8_WAIT_L(0); PG8_MMA(0, 1, At, B1); PG8_BAR;
            PG8_LDA(At, 1, 1); PG8_STAGE(PG8_SA(1, 0), a3, voffA);
            PG8_BAR; PG8_WAIT_L(0); PG8_MMA(1, 0, At, B0); PG8_BAR; PG8_SCHED;
            PG8_STAGE(PG8_SB(1, 1), b3 + hstep, voffB);
            PG8_WAIT_V(6); PG8_BAR; PG8_MMA(1, 1, At, B1); PG8_BAR;
        }
        E(acc, cur, wr, wc, fr, fq);
        if (!has_next) break;
#pragma unroll
        for (int a = 0; a < 2; ++a)
#pragma unroll
            for (int b = 0; b < 2; ++b)
#pragma unroll
                for (int m = 0; m < 4; ++m)
#pragma unroll
                    for (int n = 0; n < 2; ++n) acc[a][b][m][n] = (f32x4){0.f, 0.f, 0.f, 0.f};
        cur = nxt; cA = nA; cB = nB; ++ui;
    }
    PG8_WAIT_V(0);
    if (wr == 0) PG8_BAR;
    PG8_BAR;
#undef PG8_SA
#undef PG8_SB
#undef PG8_STAGE
#undef PG8_LDA
#undef PG8_LDB
#undef PG8_MMA
#undef PG8_WAIT_V
#undef PG8_WAIT_L
#undef PG8_BAR
#undef PG8_SCHED
}
}

DI void rms_row(const float* src, const float* g, bf16_t* dst, int lane) {
    f32x4 v[8]; float ss = 0.f;
#pragma unroll
    for (int i = 0; i < 4; ++i) { v[2 * i] = *(const f32x4*)(src + 512 * i + 8 * lane); v[2 * i + 1] = *(const f32x4*)(src + 512 * i + 8 * lane + 4); }
#pragma unroll
    for (int i = 0; i < 8; ++i) ss += v[i][0] * v[i][0] + v[i][1] * v[i][1] + v[i][2] * v[i][2] + v[i][3] * v[i][3];
#pragma unroll
    for (int m = 1; m < 64; m <<= 1) ss += shx(ss, m);
    const float rs = __builtin_amdgcn_rsqf(ss * (1.f / 2048.f) + RMS_EPS);
#pragma unroll
    for (int i = 0; i < 4; ++i) {
        const f32x4 g0 = *(const f32x4*)(g + 512 * i + 8 * lane), g1 = *(const f32x4*)(g + 512 * i + 8 * lane + 4);
        const f32x4 a = v[2 * i] * rs * g0, b = v[2 * i + 1] * rs * g1;
        u32x4 w; w.x = pk2(a[0], a[1]); w.y = pk2(a[2], a[3]); w.z = pk2(b[0], b[1]); w.w = pk2(b[2], b[3]);
        *(u32x4*)(dst + 512 * i + 8 * lane) = w;
    }
}

DI void phase0(const Params& p, unsigned char* lds, int bid, int nb, const int part) {
    const int tid = threadIdx.x, lane = tid & 63, wid = tid >> 6;
    float* tile = (float*)lds;
    constexpr int U_IN = 32 * 22, U_SQ = 32 * 8;
    for (int u = bid + (part ? U_IN : 0); u < (part ? U_IN + 2 * U_SQ : U_IN); u += nb) {
        const float* W; bf16_t* Wt; int N; int uu = u;
        if (uu < U_IN) { W = p.w_in; Wt = (bf16_t*)(p.ws + OFF_WINT); N = INC; }
        else if (uu < U_IN + U_SQ) { uu -= U_IN; W = p.w_out; Wt = (bf16_t*)(p.ws + OFF_WOUTT); N = D; }
        else { uu -= U_IN + U_SQ; W = p.peer_wq; Wt = (bf16_t*)(p.ws + OFF_WQT); N = D; }
        const bool foldg = (u >= U_IN + U_SQ);
        const int ntl = N / 256; const int k0 = (uu / ntl) * 64, n0 = (uu % ntl) * 256;
        f32x4 tv[8];
#pragma unroll
        for (int i = 0; i < 8; ++i) tv[i] = *(const f32x4*)(W + (size_t)(k0 + (tid >> 6) + 8 * i) * N + n0 + 4 * (tid & 63));
#pragma unroll
        for (int i = 0; i < 8; ++i) *(f32x4*)(tile + ((tid >> 6) + 8 * i) * 260 + 4 * (tid & 63)) = tv[i];
        __syncthreads();
#pragma unroll
        for (int i = 0; i < 4; ++i) { const int task = tid + 512 * i, n = task >> 3, kc = task & 7; float f[8];
#pragma unroll
            for (int j = 0; j < 8; ++j) { f[j] = tile[(kc * 8 + j) * 260 + n]; if (foldg) f[j] *= p.ln_ffn_g[k0 + kc * 8 + j]; }
            *(bf16x8*)(Wt + (size_t)(n0 + n) * 2048 + k0 + kc * 8) = pack8(f); }
        __syncthreads();
    }
    bf16_t* HN = (bf16_t*)(p.ws + OFF_HN);
    if (part == 0)
    for (int u = bid; u < MROWS / 16; u += nb) {
        const int r0 = (u * 8 + wid) * 2;
        if (r0 >= T + NMETA) { const u32x4 z = {0u, 0u, 0u, 0u};
#pragma unroll
            for (int rr = 0; rr < 2; ++rr)
#pragma unroll
                for (int i = 0; i < 4; ++i) *(u32x4*)(HN + (size_t)(r0 + rr) * D + 512 * i + 8 * lane) = z; }
        else {
            const float* s0 = r0 < T ? p.x + (size_t)r0 * D : p.meta + (size_t)(r0 - T) * D; const float* s1 = s0 + D;
            f32x4 va[8], vb[8];
#pragma unroll
            for (int i = 0; i < 8; ++i) { va[i] = __builtin_nontemporal_load((const f32x4*)(s0 + 256 * i + 4 * lane)); vb[i] = __builtin_nontemporal_load((const f32x4*)(s1 + 256 * i + 4 * lane)); }
            float sa = 0.f, sb = 0.f;
#pragma unroll
            for (int i = 0; i < 8; ++i) { sa += va[i][0] * va[i][0] + va[i][1] * va[i][1] + va[i][2] * va[i][2] + va[i][3] * va[i][3]; sb += vb[i][0] * vb[i][0] + vb[i][1] * vb[i][1] + vb[i][2] * vb[i][2] + vb[i][3] * vb[i][3]; }
#pragma unroll
            for (int m = 1; m < 64; m <<= 1) { sa += shx(sa, m); sb += shx(sb, m); }
            const float ra = __builtin_amdgcn_rsqf(sa * (1.f / 2048.f) + RMS_EPS), rb = __builtin_amdgcn_rsqf(sb * (1.f / 2048.f) + RMS_EPS);
#pragma unroll
            for (int i = 0; i < 8; ++i) {
                const f32x4 g0 = *(const f32x4*)(p.ln_mix_g + 256 * i + 4 * lane);
                { const f32x4 a = va[i] * ra * g0; u32x2 w; w.x = pk2(a[0], a[1]); w.y = pk2(a[2], a[3]); *(u32x2*)(HN + (size_t)r0 * D + 256 * i + 4 * lane) = w; }
                { const f32x4 a = vb[i] * rb * g0; u32x2 w; w.x = pk2(a[0], a[1]); w.y = pk2(a[2], a[3]); *(u32x2*)(HN + (size_t)(r0 + 1) * D + 256 * i + 4 * lane) = w; }
            }
        }
    }
    {
        unsigned char* UBq = p.ws + OFF_UB; unsigned char* VBq = p.ws + OFF_VB; float* SU = (float*)(p.ws + OFF_SU); float* SV = (float*)(p.ws + OFF_SV);
        auto quant_row = [&](f32x4 (&v)[8], const int which, const int e) {
            if (which == 0) {
                float ss = 0.f;
#pragma unroll
                for (int i = 0; i < 8; ++i) ss += v[i][0] * v[i][0] + v[i][1] * v[i][1] + v[i][2] * v[i][2] + v[i][3] * v[i][3];
#pragma unroll
                for (int m = 1; m < 64; m <<= 1) ss += shx(ss, m);
                const float step = 0.335f * __builtin_sqrtf(ss * (1.f / 2048.f)); const float inv = step > 0.f ? 1.f / step : 0.f;
                u32x4 w;
#pragma unroll
                for (int d = 0; d < 4; ++d) { const f32x4 t0 = v[2 * d] * inv + 8.f, t1 = v[2 * d + 1] * inv + 8.f; unsigned pw = 0u;
#pragma unroll
                    for (int j = 0; j < 4; ++j) { const int n0 = (int)fminf(fmaxf(floorf(t0[j]), 0.f), 15.f), n1 = (int)fminf(fmaxf(floorf(t1[j]), 0.f), 15.f); pw |= ((unsigned)n0 | ((unsigned)n1 << 4)) << (8 * j); }
                    w[d] = pw; }
                *(u32x4*)(UBq + (size_t)e * 1024 + 16 * lane) = w;
                if (lane == 0) SU[e] = step;
            } else {
                float am = 0.f;
#pragma unroll
                for (int i = 0; i < 8; ++i) am = fmaxf(fmaxf(fmaxf(am, fabsf(v[i][0])), fmaxf(fabsf(v[i][1]), fabsf(v[i][2]))), fabsf(v[i][3]));
#pragma unroll
                for (int m = 1; m < 64; m <<= 1) am = fmaxf(am, shx(am, m));
                const float sc = am > 0.f ? 6.f / am : 0.f, isc = am * (1.f / 6.f);
                u32x4 w;
#pragma unroll
                for (int d = 0; d < 4; ++d) { const f32x4 t0 = v[2 * d] * sc, t1 = v[2 * d + 1] * sc; unsigned pw = 0u;
                    pw = __builtin_amdgcn_cvt_scalef32_pk_fp4_f32(pw, t0[0], t0[1], 1.0f, 0); pw = __builtin_amdgcn_cvt_scalef32_pk_fp4_f32(pw, t0[2], t0[3], 1.0f, 1);
                    pw = __builtin_amdgcn_cvt_scalef32_pk_fp4_f32(pw, t1[0], t1[1], 1.0f, 2); pw = __builtin_amdgcn_cvt_scalef32_pk_fp4_f32(pw, t1[2], t1[3], 1.0f, 3); w[d] = pw; }
                *(u32x4*)(VBq + (size_t)e * 1024 + 16 * lane) = w;
                if (lane == 0) SV[e] = isc;
            }
        };
        if (part == 1)
        for (int u = bid; u < 2048; u += nb) {
            const int rowi = (u * 8 + wid) * 2; const int which = rowi >> 14, e = rowi & 16383;
            const float* src = (which ? p.peer_v : p.peer_u) + (size_t)e * D + 4 * lane;
            f32x4 va[8], vb[8];
#pragma unroll
            for (int i = 0; i < 8; ++i) { va[i] = *(const f32x4*)(src + 256 * i); vb[i] = *(const f32x4*)(src + D + 256 * i); }
            if (which == 0) {
#pragma unroll
                for (int i = 0; i < 8; ++i) { const f32x4 gg = *(const f32x4*)(p.ln_ffn_g + 4 * lane + 256 * i); va[i] = va[i] * gg; vb[i] = vb[i] * gg; } }
            quant_row(va, which, e); quant_row(vb, which, e + 1);
        }
    }
    if (part == 1)
    for (int u = bid; u < 64; u += nb) {
        const size_t idx = ((size_t)u * 512 + tid) * 8; const float* src = p.sub_keys + idx; bf16_t* dst = (bf16_t*)(p.ws + OFF_SK) + idx;
        const f32x4 a = *(const f32x4*)src, b = *(const f32x4*)(src + 4);
        u32x4 w; w.x = pk2(a[0], a[1]); w.y = pk2(a[2], a[3]); w.z = pk2(b[0], b[1]); w.w = pk2(b[2], b[3]);
        *(u32x4*)dst = w;
    }
    float* ROPE = (float*)(p.ws + OFF_ROPE);
    if (part == 0)
    for (int u = bid; u < 65; u += nb) {
        const int idx = u * 512 + tid;
        if (idx < 2064 * 16) { const int pos = idx >> 4, i = idx & 15;
            const float inv = exp2f(-(float)i * (18.931568569324174f / 16.f));
            const float ang = (float)pos * inv; const float rev = ang * 0.15915494309189535f; const float fr = rev - floorf(rev);
            ROPE[pos * 32 + i] = __builtin_amdgcn_cosf(fr); ROPE[pos * 32 + 16 + i] = __builtin_amdgcn_sinf(fr); }
    }
    float* LB = (float*)(p.ws + OFF_LB);
    if (part == 0)
    for (int u = bid; u < 2; u += nb) { const int k = u * 512 + tid; LB[k] = 1.f / (1.f + __expf(p.lb_logits[1024 + k] - p.lb_logits[k])); }
}

DI void phase_norm2(const Params& p, int bid, int nb) {
    const int lane = threadIdx.x & 63, wid = threadIdx.x >> 6;
    bf16_t* XN = (bf16_t*)(p.ws + OFF_HN);
    for (int u = bid; u < T / 8; u += nb) { const int r = u * 8 + wid; rms_row(p.out + (size_t)r * D, p.ln_ffn_g, XN + (size_t)r * D, lane); }
}

DI void attn_item(const Params& p, unsigned char* lds, int item) {
    const int kvh = item & 1, nbk = (item >> 1) & 15, b = item >> 5;
    const int tid = threadIdx.x, lane = tid & 63, wid = tid >> 6, h5 = lane >> 5, l31 = lane & 31;
    bf16_t* Ks = (bf16_t*)lds;
    bf16_t* Vt = (bf16_t*)(lds + 288 * 272);
    const bf16_t* proj = (const bf16_t*)(p.ws + OFF_PROJ);
    const float* ROPE = (const float*)(p.ws + OFF_ROPE);
    {
        const int sub = tid & 15, rp = tid >> 4;
        float kg[8];
#pragma unroll
        for (int j = 0; j < 8; ++j) kg[j] = p.k_norm_g[sub * 8 + j];
#pragma unroll 1
        for (int pg = 0; pg < 9; pg += 3) {
        u32x4 raws[3];
#pragma unroll
        for (int pass = pg; pass < pg + 3; ++pass) {
            const int slot = pass * 32 + rp; int row = -1;
            if (slot < 16) row = T + slot;
            else if (slot >= 32) { const int s = 128 * (nbk - 1) + (slot - 32); if (s >= 0) row = b * SEQ + s; }
            raws[pass - pg] = (u32x4){0u, 0u, 0u, 0u};
            if (row >= 0) raws[pass - pg] = *(const u32x4*)(proj + (size_t)row * INC + COL_K + kvh * 128 + sub * 8);
        }
#pragma unroll
        for (int pass = pg; pass < pg + 3; ++pass) {
            const int slot = pass * 32 + rp; int row = -1, pos = 0;
            if (slot < 16) { row = T + slot; pos = slot; }
            else if (slot >= 32) { const int s = 128 * (nbk - 1) + (slot - 32); if (s >= 0) { row = b * SEQ + s; pos = NMETA + s; } }
            const u32x4 raw = raws[pass - pg];
            float f[8]; unpack8(raw, f);
            float ss = 0.f;
#pragma unroll
            for (int j = 0; j < 8; ++j) ss += f[j] * f[j];
            ss += shx(ss, 1); ss += shx(ss, 2); ss += shx(ss, 4); ss += shx(ss, 8);
            const float rs = __builtin_amdgcn_rsqf(ss * (1.f / 128.f) + RMS_EPS);
            float pr[8];
#pragma unroll
            for (int j = 0; j < 8; ++j) { f[j] = f[j] * rs * kg[j]; pr[j] = shx(f[j], 2); }
            if (sub < 4 && row >= 0) { const float* cs = ROPE + pos * 32 + (sub & 1) * 8;
#pragma unroll
                for (int j = 0; j < 8; ++j) { const float c = cs[j], s = cs[16 + j]; f[j] = (sub < 2) ? (f[j] * c - pr[j] * s) : (f[j] * c + pr[j] * s); } }
            *(bf16x8*)(Ks + slot * 136 + sub * 8) = pack8(f);
        }
        }
    }
    {
#pragma unroll 1
        for (int ig = 0; ig < 9; ig += 3) {
        u32x4 raws[3];
#pragma unroll
        for (int it = ig; it < ig + 3; ++it) {
            const int idx = it * 512 + tid; const int key = idx % 288, dc = idx / 288; int row = -1;
            if (key < 16) row = T + key;
            else if (key >= 32) { const int s = 128 * (nbk - 1) + (key - 32); if (s >= 0) row = b * SEQ + s; }
            raws[it - ig] = (u32x4){0u, 0u, 0u, 0u};
            if (row >= 0) raws[it - ig] = *(const u32x4*)(proj + (size_t)row * INC + COL_V + kvh * 128 + dc * 8);
        }
#pragma unroll
        for (int it = ig; it < ig + 3; ++it) {
            const int idx = it * 512 + tid; const int key = idx % 288, dc = idx / 288;
            const u32x4 raw = raws[it - ig];
            bf16_t* vp = Vt + (dc * 8) * 292 + key;
            vp[0 * 292] = (bf16_t)(raw.x & 0xffffu); vp[1 * 292] = (bf16_t)(raw.x >> 16); vp[2 * 292] = (bf16_t)(raw.y & 0xffffu); vp[3 * 292] = (bf16_t)(raw.y >> 16);
            vp[4 * 292] = (bf16_t)(raw.z & 0xffffu); vp[5 * 292] = (bf16_t)(raw.z >> 16); vp[6 * 292] = (bf16_t)(raw.w & 0xffffu); vp[7 * 292] = (bf16_t)(raw.w >> 16);
        }
        }
    }
    __syncthreads();
    const int hq = kvh * 4 + (wid >> 1);
    const float sinkv = p.sinks[hq] * LOG2E;
    bf16_t* MIX = (bf16_t*)(p.ws + OFF_MIX);
#pragma unroll 1
    for (int qq = 0; qq < 2; ++qq) {
        const int qt = (wid & 1) * 2 + qq; const int iq = 32 * qt + l31; const int s = 128 * nbk + iq; const size_t row = (size_t)b * SEQ + s;
        bf16x8 qf[8];
        {
            u32x4 raw[8]; float ss = 0.f;
#pragma unroll
            for (int ks = 0; ks < 8; ++ks) { raw[ks] = *(const u32x4*)(proj + row * INC + hq * 128 + 16 * ks + 8 * h5); float f[8]; unpack8(raw[ks], f);
#pragma unroll
                for (int j = 0; j < 8; ++j) ss += f[j] * f[j]; }
            ss += shx(ss, 32);
            const float rs = __builtin_amdgcn_rsqf(ss * (1.f / 128.f) + RMS_EPS) * (0.08838834764831845f * LOG2E);
            {
                float f0[8], f1[8]; unpack8(raw[0], f0); unpack8(raw[1], f1);
                const float* cs = ROPE + (NMETA + s) * 32 + 8 * h5;
#pragma unroll
                for (int j = 0; j < 8; ++j) { const float c = cs[j], sn = cs[16 + j]; const float x1 = f0[j] * rs * p.q_norm_g[8 * h5 + j], x2 = f1[j] * rs * p.q_norm_g[16 + 8 * h5 + j];
                    f0[j] = x1 * c - x2 * sn; f1[j] = x2 * c + x1 * sn; }
                qf[0] = pack8(f0); qf[1] = pack8(f1);
            }
#pragma unroll
            for (int ks = 2; ks < 8; ++ks) { float f[8]; unpack8(raw[ks], f);
#pragma unroll
                for (int j = 0; j < 8; ++j) f[j] *= rs * p.q_norm_g[16 * ks + 8 * h5 + j];
                qf[ks] = pack8(f); }
        }
        float m = sinkv, l = 1.f;
        f32x16 O[4];
#pragma unroll
        for (int dt = 0; dt < 4; ++dt)
#pragma unroll
            for (int r = 0; r < 16; ++r) O[dt][r] = 0.f;
#pragma unroll 1
        for (int kt = -1; kt < 5; ++kt) {
            const int ktc = qt + kt; int slot0 = 0;
            if (kt >= 0) { if (nbk == 0 && ktc < 4) continue; slot0 = 32 + 32 * ktc; }
            f32x16 S;
#pragma unroll
            for (int r = 0; r < 16; ++r) S[r] = 0.f;
#pragma unroll
            for (int ks = 0; ks < 8; ++ks) { const bf16x8 kf = *(const bf16x8*)(Ks + (slot0 + l31) * 136 + 16 * ks + 8 * h5); S = mfma32(kf, qf[ks], S); }
            float tmax = -1e30f;
#pragma unroll
            for (int r = 0; r < 16; ++r) { const int kr = (r & 3) + 8 * (r >> 2) + 4 * h5; bool valid;
                if (kt < 0) valid = kr < 16; else { const int c = 32 * ktc + kr; valid = (c > iq) && (c <= 128 + iq) && (nbk > 0 || c >= 128); }
                S[r] = valid ? S[r] : -1e30f; tmax = fmaxf(tmax, S[r]); }
            tmax = fmaxf(tmax, shx(tmax, 32));
            const float mn = fmaxf(m, tmax); const float alpha = __builtin_amdgcn_exp2f(m - mn);
            float psum = 0.f;
#pragma unroll
            for (int r = 0; r < 16; ++r) { const float pv = __builtin_amdgcn_exp2f(S[r] - mn); psum += pv; S[r] = pv; }
            psum += shx(psum, 32);
            l = l * alpha + psum; m = mn;
#pragma unroll
            for (int dt = 0; dt < 4; ++dt)
#pragma unroll
                for (int r = 0; r < 16; ++r) O[dt][r] *= alpha;
#pragma unroll
            for (int sx = 0; sx < 2; ++sx) {
                float pf[8];
#pragma unroll
                for (int j = 0; j < 8; ++j) pf[j] = S[8 * sx + j];
                const bf16x8 pfr = pack8(pf);
#pragma unroll
                for (int dt = 0; dt < 4; ++dt) {
                    const bf16_t* vb = Vt + (32 * dt + l31) * 292 + slot0 + 16 * sx + 4 * h5;
                    const s16x4 lo = *(const s16x4*)vb, hi = *(const s16x4*)(vb + 8);
                    bf16x8 vf; vf[0] = lo[0]; vf[1] = lo[1]; vf[2] = lo[2]; vf[3] = lo[3]; vf[4] = hi[0]; vf[5] = hi[1]; vf[6] = hi[2]; vf[7] = hi[3];
                    O[dt] = mfma32(vf, pfr, O[dt]);
                }
            }
        }
        const float inv_l = 1.f / l;
        bf16_t* orow = MIX + row * D + hq * 128;
#pragma unroll
        for (int dt = 0; dt < 4; ++dt)
#pragma unroll
            for (int g4 = 0; g4 < 4; ++g4) { u32x2 w; w.x = pk2(O[dt][4 * g4] * inv_l, O[dt][4 * g4 + 1] * inv_l); w.y = pk2(O[dt][4 * g4 + 2] * inv_l, O[dt][4 * g4 + 3] * inv_l);
                *(u32x2*)(orow + 32 * dt + 8 * g4 + 4 * h5) = w; }
    }
    __syncthreads();
}

DI void lds_barrier() { asm volatile("s_waitcnt lgkmcnt(0)" ::: "memory"); __builtin_amdgcn_s_barrier(); asm volatile("" ::: "memory"); }
DI void hgrn_item(const Params& p, unsigned char* lds, int item) {
    const int h = item & 7, b = item >> 3;
    const int tid = threadIdx.x, lane = tid & 63, wid = tid >> 6, g = lane >> 4, l15 = lane & 15;
    bf16_t* QT = (bf16_t*)lds;
    bf16_t* KT = QT + 64 * 136;
    bf16_t* QB = KT + 64 * 136;
    bf16_t* KDT = QB + 64 * 136;
    bf16_t* VT = KDT + 128 * 72;
    bf16_t* SC = VT + 128 * 72;
    float* OL = (float*)(SC + 64 * 72);
    float* GT = OL + 64 * 132;
    float* BL = GT + 1024;
    const bf16_t* proj = (const bf16_t*)(p.ws + OFF_PROJ);
    bf16_t* MIX = (bf16_t*)(p.ws + OFF_MIX);
    const int kp = tid & 63, tg = tid >> 6;
    const float c1a = 1.f - ((const float*)(p.ws + OFF_LB))[h * 128 + 2 * kp], c1b = 1.f - ((const float*)(p.ws + OFF_LB))[h * 128 + 2 * kp + 1];
    const int vs = tid & 63, vc = tid >> 6;
    const int et = tid >> 3, eseg = tid & 7;
    float* GNL = BL + 128;
    if (tid < 128) GNL[tid] = p.hgrn_norm_g[h * 128 + tid];
    f32x4 S[8];
#pragma unroll
    for (int mt = 0; mt < 8; ++mt) S[mt] = (f32x4){0.f, 0.f, 0.f, 0.f};
    unsigned nq[8], nf[8]; u32x4 nva, nvb, nga, ngb;
    auto prefetch = [&](int c) {
#pragma unroll
        for (int i = 0; i < 8; ++i) { const int t = 8 * tg + i; int row;
            if (c == 0) row = T + max(t - 48, 0); else row = b * SEQ + 64 * (c - 1) + t;
            const bf16_t* pr = proj + (size_t)row * INC + h * 128 + 2 * kp; nf[i] = *(const unsigned*)(pr + COL_HF); nq[i] = *(const unsigned*)(pr + COL_HQ); }
        { int row; if (c == 0) row = T + max(vs - 48, 0); else row = b * SEQ + 64 * (c - 1) + vs;
          const bf16_t* pr = proj + (size_t)row * INC + COL_HI + h * 128 + 16 * vc; nva = *(const u32x4*)pr; nvb = *(const u32x4*)(pr + 8); }
        { const int cc = c > 0 ? c - 1 : 0; const bf16_t* gp = proj + ((size_t)b * SEQ + 64 * cc + et) * INC + COL_HG + h * 128 + 16 * eseg; nga = *(const u32x4*)gp; ngb = *(const u32x4*)(gp + 8); }
    };
    prefetch(0);
    for (int c = 0; c < 33; ++c) {
        unsigned cq[8], cf[8];
#pragma unroll
        for (int i = 0; i < 8; ++i) { cq[i] = nq[i]; cf[i] = nf[i]; }
        const bool vvalid = !(c == 0 && vs < 48); const u32x4 z4 = {0u, 0u, 0u, 0u};
        const u32x4 cva = vvalid ? nva : z4, cvb = vvalid ? nvb : z4, cga = nga, cgb = ngb;
        const bool padchunk = (c == 0);
        if (c < 32) prefetch(c + 1);
        {
            float bl[8][2], qs[8][2], kk[8][2]; float csa = 1.f, csb = 1.f;
#pragma unroll
            for (int i = 0; i < 8; ++i) {
                const int t = 8 * tg + i; const bool valid = !(padchunk && t < 48);
                const float ka = valid ? c1a * bf_lo(cf[i]) : 0.f, kb = valid ? c1b * bf_hi(cf[i]) : 0.f;
                csa *= (1.f - ka); csb *= (1.f - kb); bl[i][0] = csa; bl[i][1] = csb;
                qs[i][0] = valid ? bf_lo(cq[i]) : 0.f; qs[i][1] = valid ? bf_hi(cq[i]) : 0.f; kk[i][0] = ka; kk[i][1] = kb;
            }
            *(f32x2*)(GT + tg * 128 + 2 * kp) = (f32x2){csa, csb};
            {
                bf16_t* vp = VT + (16 * vc) * 72 + vs;
                vp[0 * 72] = (bf16_t)(cva.x & 0xffffu); vp[1 * 72] = (bf16_t)(cva.x >> 16); vp[2 * 72] = (bf16_t)(cva.y & 0xffffu); vp[3 * 72] = (bf16_t)(cva.y >> 16);
                vp[4 * 72] = (bf16_t)(cva.z & 0xffffu); vp[5 * 72] = (bf16_t)(cva.z >> 16); vp[6 * 72] = (bf16_t)(cva.w & 0xffffu); vp[7 * 72] = (bf16_t)(cva.w >> 16);
                vp[8 * 72] = (bf16_t)(cvb.x & 0xffffu); vp[9 * 72] = (bf16_t)(cvb.x >> 16); vp[10 * 72] = (bf16_t)(cvb.y & 0xffffu); vp[11 * 72] = (bf16_t)(cvb.y >> 16);
                vp[12 * 72] = (bf16_t)(cvb.z & 0xffffu); vp[13 * 72] = (bf16_t)(cvb.z >> 16); vp[14 * 72] = (bf16_t)(cvb.w & 0xffffu); vp[15 * 72] = (bf16_t)(cvb.w >> 16);
            }
            lds_barrier();
            f32x2 off = {1.f, 1.f}, er = {1.f, 1.f}, ebr = {1.f, 1.f};
#pragma unroll
            for (int gi = 0; gi < 8; ++gi) { const f32x2 gp = *(const f32x2*)(GT + gi * 128 + 2 * kp);
                if (gi < tg) off = off * gp;
                if (gi < 4) er = er * gp; else ebr = ebr * gp; }
            const f32x2 plast = er * ebr;
            const float iera = fast_rcp(fmaxf(er[0], 1e-30f)), ierb = fast_rcp(fmaxf(er[1], 1e-30f));
            float kda[8], kdb[8];
#pragma unroll
            for (int i = 0; i < 8; ++i) {
                const int t = 8 * tg + i; const float pta = off[0] * bl[i][0], ptb = off[1] * bl[i][1];
                const float eqa = fminf(fmaxf(pta * iera, 1e-30f), 1e30f), eqb = fminf(fmaxf(ptb * ierb, 1e-30f), 1e30f);
                const float eka = fast_rcp(eqa), ekb = fast_rcp(eqb);
                const float kea = kk[i][0] * eka, keb = kk[i][1] * ekb;
                *(unsigned*)(QT + t * 136 + 2 * kp) = pk2(qs[i][0] * eqa, qs[i][1] * eqb);
                *(unsigned*)(KT + t * 136 + 2 * kp) = pk2(kea, keb);
                *(unsigned*)(QB + t * 136 + 2 * kp) = pk2(qs[i][0] * pta, qs[i][1] * ptb);
                kda[i] = kea * ebr[0]; kdb[i] = keb * ebr[1];
            }
            *(bf16x8*)(KDT + (2 * kp) * 72 + 8 * tg) = pack8(kda); *(bf16x8*)(KDT + (2 * kp + 1) * 72 + 8 * tg) = pack8(kdb);
            if (tg == 0) *(f32x2*)(BL + 2 * kp) = plast;
        }
        lds_barrier();
#pragma unroll
        for (int q = 0; q < 2; ++q) {
            const int id = 2 * wid + q, ti = id >> 2, si = id & 3;
            f32x4 acc = {0.f, 0.f, 0.f, 0.f};
            if (si <= ti) {
#pragma unroll
                for (int ks = 0; ks < 4; ++ks) { const bf16x8 a = *(const bf16x8*)(QT + (16 * ti + l15) * 136 + 32 * ks + 8 * g); const bf16x8 bb = *(const bf16x8*)(KT + (16 * si + l15) * 136 + 32 * ks + 8 * g); acc = mfma16(a, bb, acc); }
            }
#pragma unroll
            for (int i = 0; i < 4; ++i) { const int t = 16 * ti + 4 * g + i, s = 16 * si + l15; SC[t * 72 + s] = f2bf((s <= t) ? acc[i] : 0.f); }
        }
        f32x4 oacc[4];
        {
            bf16x8 sb[4];
#pragma unroll
            for (int ks = 0; ks < 4; ++ks) { float f[8];
#pragma unroll
                for (int j = 0; j < 4; ++j) { f[j] = S[2 * ks][j]; f[4 + j] = S[2 * ks + 1][j]; }
                sb[ks] = pack8(f); }
#pragma unroll
            for (int mt = 0; mt < 4; ++mt) {
                f32x4 acc = {0.f, 0.f, 0.f, 0.f};
#pragma unroll
                for (int ks = 0; ks < 4; ++ks) { const bf16_t* qp = QB + (16 * mt + l15) * 136 + 32 * ks + 4 * g; const s16x4 lo = *(const s16x4*)qp, hi = *(const s16x4*)(qp + 16);
                    bf16x8 a; a[0] = lo[0]; a[1] = lo[1]; a[2] = lo[2]; a[3] = lo[3]; a[4] = hi[0]; a[5] = hi[1]; a[6] = hi[2]; a[7] = hi[3];
                    acc = mfma16(a, sb[ks], acc); }
                oacc[mt] = acc;
            }
#pragma unroll
            for (int mt = 0; mt < 8; ++mt) {
                const f32x4 e4 = *(const f32x4*)(BL + 16 * mt + 4 * g);
                S[mt] = S[mt] * e4;
#pragma unroll
                for (int ks = 0; ks < 2; ++ks) { const bf16x8 a = *(const bf16x8*)(KDT + (16 * mt + l15) * 72 + 32 * ks + 8 * g); const bf16x8 bv = *(const bf16x8*)(VT + (16 * wid + l15) * 72 + 32 * ks + 8 * g); S[mt] = mfma16(a, bv, S[mt]); }
            }
        }
        lds_barrier();
#pragma unroll
        for (int mt = 0; mt < 4; ++mt) {
            f32x4 acc = oacc[mt];
#pragma unroll
            for (int ks = 0; ks < 2; ++ks) { const bf16x8 a = *(const bf16x8*)(SC + (16 * mt + l15) * 72 + 32 * ks + 8 * g); const bf16x8 bv = *(const bf16x8*)(VT + (16 * wid + l15) * 72 + 32 * ks + 8 * g); acc = mfma16(a, bv, acc); }
#pragma unroll
            for (int i = 0; i < 4; ++i) OL[(16 * mt + 4 * g + i) * 132 + 16 * wid + l15] = acc[i];
        }
        lds_barrier();
        if (c > 0) {
            const size_t row = (size_t)b * SEQ + 64 * (c - 1) + et;
            float o[16]; float ss = 0.f;
#pragma unroll
            for (int i = 0; i < 4; ++i) { const f32x4 v = *(const f32x4*)(OL + et * 132 + 16 * eseg + 4 * i); o[4 * i] = v[0]; o[4 * i + 1] = v[1]; o[4 * i + 2] = v[2]; o[4 * i + 3] = v[3]; }
#pragma unroll
            for (int i = 0; i < 16; ++i) ss += o[i] * o[i];
            ss += shx(ss, 1); ss += shx(ss, 2); ss += shx(ss, 4);
            const float rs = __builtin_amdgcn_rsqf(ss * (1.f / 128.f) + RMS_EPS);
            float hg[16]; unpack8(cga, hg); unpack8(cgb, hg + 8);
            float gn[16];
#pragma unroll
            for (int i = 0; i < 4; ++i) { const f32x4 v = *(const f32x4*)(GNL + 16 * eseg + 4 * i); gn[4 * i] = v[0]; gn[4 * i + 1] = v[1]; gn[4 * i + 2] = v[2]; gn[4 * i + 3] = v[3]; }
            float outv[16];
#pragma unroll
            for (int i = 0; i < 16; ++i) outv[i] = o[i] * rs * gn[i] * hg[i];
            bf16_t* op = MIX + row * D + 1024 + h * 128 + 16 * eseg;
            *(bf16x8*)op = pack8(outv); *(bf16x8*)(op + 8) = pack8(outv + 8);
        }
    }
}

DI int sortable(float f) { const int b = __float_as_int(f); return b ^ ((b >> 31) & 0x7fffffff); }
DI float unsortable(int k) { return __int_as_float(k ^ ((k >> 31) & 0x7fffffff)); }
#define TOPK_INSERT(top, xval) do { int _x = (xval); _Pragma("unroll") for (int _j = 0; _j < 16; ++_j) { const int _hi = max((top)[_j], _x); _x = min((top)[_j], _x); (top)[_j] = _hi; } } while (0)

DI void cex_desc(int& hi, int& lo) { const int a = max(hi, lo), b = min(hi, lo); hi = a; lo = b; }
DI void bitonic_sort16_desc(int (&a)[16]) {
#pragma unroll
    for (int k = 2; k <= 16; k <<= 1)
#pragma unroll
        for (int j = k >> 1; j > 0; j >>= 1)
#pragma unroll
            for (int i = 0; i < 16; ++i) { const int l = i ^ j; if (l > i) { if ((i & k) == 0) cex_desc(a[i], a[l]); else cex_desc(a[l], a[i]); } }
}
DI void merge_top16(int (&top)[16], const int (&g)[16]) {
#pragma unroll
    for (int i = 0; i < 16; ++i) top[i] = max(top[i], g[15 - i]);
#pragma unroll
    for (int j = 8; j > 0; j >>= 1)
#pragma unroll
        for (int i = 0; i < 16; ++i) { const int l = i ^ j; if (l > i) cex_desc(top[i], top[l]); }
}
DI void peer_unit(const Params& p, unsigned char* lds, int unit, const int mode = 0) {
    const int t0 = unit * 32;
    int* SELI = (int*)lds;
    float* SELG = (float*)(lds + 16384);
    const int tid = threadIdx.x, lane = tid & 63, wid = tid >> 6, h5 = lane >> 5, l31 = lane & 31;
    const bf16_t* pq = (const bf16_t*)(p.ws + OFF_PROJ);
    const bf16_t* skb = (const bf16_t*)(p.ws + OFF_SK);
    const bf16_t* XN = (const bf16_t*)(p.ws + OFF_HN);
    const bf16_t* UB = (const bf16_t*)(p.ws + OFF_UB);
    const bf16_t* VB = (const bf16_t*)(p.ws + OFF_VB);
    float* RSL = (float*)(lds + 32768);
    if (mode != 2) {
    for (int q = 0; q < 4; ++q) {
        const int tl = 4 * wid + q; const bf16_t* xp = XN + ((size_t)t0 + tl) * D + 16 * lane; float ss = 0.f;
#pragma unroll
        for (int r = 0; r < 2; ++r) { float f[16]; unpack8(*(const u32x4*)(xp + 1024 * r), f); unpack8(*(const u32x4*)(xp + 1024 * r + 8), f + 8);
#pragma unroll
            for (int i = 0; i < 16; ++i) ss += f[i] * f[i]; }
#pragma unroll
        for (int m = 1; m < 64; m <<= 1) ss += shx(ss, m);
        if (lane == 0) RSL[tl] = __builtin_amdgcn_rsqf(ss * (1.f / 2048.f) + RMS_EPS);
    }
    __syncthreads();
    {
        const int hd = wid; const size_t tok = (size_t)t0 + l31; const float rstok = RSL[l31];
        int top0[16], top1[16];
#pragma unroll
        for (int c = 0; c < 2; ++c) {
            int top[16];
#pragma unroll
            for (int j = 0; j < 16; ++j) top[j] = (int)0x80000000;
            bf16x8 qf[8];
#pragma unroll
            for (int ks = 0; ks < 8; ++ks) qf[ks] = *(const bf16x8*)(pq + tok * D + (hd * 2 + c) * 128 + 16 * ks + 8 * h5);
            bf16x8 kf[8];
#pragma unroll
            for (int ks = 0; ks < 8; ++ks) kf[ks] = *(const bf16x8*)(skb + (size_t)((hd * 2 + c) * 128 + l31) * 128 + 16 * ks + 8 * h5);
#pragma unroll 1
            for (int mt = 0; mt < 4; ++mt) {
                bf16x8 kn[8]; const int mn = mt < 3 ? mt + 1 : mt;
#pragma unroll
                for (int ks = 0; ks < 8; ++ks) kn[ks] = *(const bf16x8*)(skb + (size_t)((hd * 2 + c) * 128 + 32 * mn + l31) * 128 + 16 * ks + 8 * h5);
                f32x16 acc;
#pragma unroll
                for (int r = 0; r < 16; ++r) acc[r] = 0.f;
#pragma unroll
                for (int ks = 0; ks < 8; ++ks) acc = mfma32(kf[ks], qf[ks], acc);
#pragma unroll
                for (int ks = 0; ks < 8; ++ks) kf[ks] = kn[ks];
                int grp[16];
#pragma unroll
                for (int r = 0; r < 16; ++r) { const int n = 32 * mt + (r & 3) + 8 * (r >> 2) + 4 * h5; grp[r] = (sortable(acc[r]) & ~127) | n; }
                bitonic_sort16_desc(grp); merge_top16(top, grp);
            }
            int other[16];
#pragma unroll
            for (int j = 0; j < 16; ++j) other[j] = shxi(top[j], 32);
            merge_top16(top, other);
#pragma unroll
            for (int j = 0; j < 16; ++j) { if (c == 0) top0[j] = top[j]; else top1[j] = top[j]; }
        }
        float v1[16], v2[16];
#pragma unroll
        for (int j = 0; j < 16; ++j) { v1[j] = unsortable(top0[j] & ~127); v2[j] = unsortable(top1[j] & ~127); }
        int c0[16], c1[16], c2[16], c3[16];
#pragma unroll
        for (int j = 0; j < 16; ++j) { c3[j] = (int)0x80000000; }
#pragma unroll
        for (int i = 0; i < 16; ++i)
#pragma unroll
            for (int j = 0; j < 16; ++j)
                if ((i + 1) * (j + 1) <= 16) {
                    int idx = j;
#pragma unroll
                    for (int a = 0; a < 16; ++a) if (a < i) idx += 16 / (a + 1);
                    const float val = v1[i] + v2[j]; const int key = (sortable(val) & ~255) | (i << 4) | j;
                    if (idx < 16) c0[idx] = key; else if (idx < 32) c1[idx - 16] = key; else if (idx < 48) c2[idx - 32] = key; else c3[idx - 48] = key;
                }
        bitonic_sort16_desc(c0); bitonic_sort16_desc(c1); bitonic_sort16_desc(c2); bitonic_sort16_desc(c3);
        merge_top16(c0, c1); merge_top16(c2, c3); merge_top16(c0, c2);
        int best[16];
#pragma unroll
        for (int j = 0; j < 16; ++j) best[j] = c0[j];
        unsigned char* IDXB = lds + 34816 + wid * 2048; unsigned* IDXW = (unsigned*)IDXB;
#pragma unroll
        for (int jq = 0; jq < 4; ++jq) {
            IDXW[jq * 64 + lane] = (unsigned)(top0[4 * jq] & 127) | ((unsigned)(top0[4 * jq + 1] & 127) << 8) | ((unsigned)(top0[4 * jq + 2] & 127) << 16) | ((unsigned)(top0[4 * jq + 3] & 127) << 24);
            IDXW[(4 + jq) * 64 + lane] = (unsigned)(top1[4 * jq] & 127) | ((unsigned)(top1[4 * jq + 1] & 127) << 8) | ((unsigned)(top1[4 * jq + 2] & 127) << 16) | ((unsigned)(top1[4 * jq + 3] & 127) << 24);
        }
        const float mval = unsortable(best[0] & ~255);
        float ev[16]; int ei[16]; float sum = 0.f;
#pragma unroll
        for (int kx = 0; kx < 16; ++kx) {
            const int ij = best[kx] & 255, i = ij >> 4, j = ij & 15;
            const int n1 = IDXB[((i >> 2) * 64 + lane) * 4 + (i & 3)], n2 = IDXB[((4 + (j >> 2)) * 64 + lane) * 4 + (j & 3)];
            ei[kx] = n1 * 128 + n2; ev[kx] = fast_exp((unsortable(best[kx] & ~255) - mval) * rstok); sum += ev[kx];
        }
        const float rsum = 1.f / sum;
        if (lane < 32) {
#pragma unroll
            for (int kx = 0; kx < 16; ++kx) { SELI[l31 * 128 + hd * 16 + kx] = ei[kx]; SELG[l31 * 128 + hd * 16 + kx] = ev[kx] * rsum; }
        }
    }
    }
    __syncthreads();
    if (mode != 1) {
    const unsigned char* UBq = p.ws + OFF_UB; const unsigned char* VBq = p.ws + OFF_VB; const float* SU = (const float*)(p.ws + OFF_SU); const float* SV = (const float*)(p.ws + OFF_SV);
    for (int q = 0; q < 4; ++q) {
        const int tl = 4 * wid + q; const size_t tok = (size_t)t0 + tl;
        unsigned xq[8]; float sx; float sumx;
        {
            float xf[32];
            const bf16_t* xp = XN + tok * D + 4 * lane;
#pragma unroll
            for (int i = 0; i < 8; ++i) { const u32x2 w = *(const u32x2*)(xp + 256 * i); xf[4 * i] = bf_lo(w.x); xf[4 * i + 1] = bf_hi(w.x); xf[4 * i + 2] = bf_lo(w.y); xf[4 * i + 3] = bf_hi(w.y); }
            float am = 0.f;
#pragma unroll
            for (int i = 0; i < 32; ++i) am = fmaxf(am, fabsf(xf[i]));
#pragma unroll
            for (int m = 1; m < 64; m <<= 1) am = fmaxf(am, shx(am, m));
            const float inv = am > 0.f ? 127.f / am : 0.f; sx = am * (1.f / 127.f);
            int isum = 0;
#pragma unroll
            for (int i = 0; i < 8; ++i) { const float* f = xf + 4 * i;
                const int q0 = (int)rintf(f[0] * inv), q1 = (int)rintf(f[1] * inv), q2 = (int)rintf(f[2] * inv), q3 = (int)rintf(f[3] * inv); isum += q0 + q1 + q2 + q3;
                xq[i] = (unsigned)(q0 & 0xff) | ((unsigned)(q1 & 0xff) << 8) | ((unsigned)(q2 & 0xff) << 16) | ((unsigned)(q3 & 0xff) << 24); }
            sumx = (float)isum;
#pragma unroll
            for (int m = 1; m < 64; m <<= 1) sumx += shx(sumx, m);
        }
        const int e_lo = SELI[tl * 128 + lane], e_hi = SELI[tl * 128 + 64 + lane];
        const float g_lo = SELG[tl * 128 + lane], g_hi = SELG[tl * 128 + 64 + lane];
        const float sxr = sx * RSL[tl];
        const float su_lo = SU[e_lo] * sxr, su_hi = SU[e_hi] * sxr, sv_lo = SV[e_lo], sv_hi = SV[e_hi];
        float a_lo = 0.f, a_hi = 0.f;
        u32x4 B0[8], B1[8];
        auto loadRows = [&](u32x4 (&buf)[8], const unsigned char* tab, int j) {
            const int esrc = j < 8 ? e_lo : e_hi;
#pragma unroll
            for (int i = 0; i < 8; ++i) { const int eid = __builtin_amdgcn_readlane(esrc, (j & 7) * 8 + i); buf[i] = *(const u32x4*)(tab + (size_t)eid * 1024 + 16 * lane); }
        };
        auto procU = [&](const u32x4 (&buf)[8], int j) {
            float ps[8];
#pragma unroll
            for (int i = 0; i < 8; ++i) { const u32x4 uu = buf[i]; int acc = 0;
#pragma unroll
                for (int d = 0; d < 4; ++d) { const unsigned wv = uu[d];
                    acc = __builtin_amdgcn_sdot4((int)(wv & 0x0f0f0f0fu), (int)xq[2 * d], acc, false); acc = __builtin_amdgcn_sdot4((int)((wv >> 4) & 0x0f0f0f0fu), (int)xq[2 * d + 1], acc, false); }
                ps[i] = (float)acc; }
            float q1[4], q2[2];
#pragma unroll
            for (int i = 0; i < 4; ++i) { const bool o = lane & 1; const float keep = o ? ps[2 * i + 1] : ps[2 * i], send = o ? ps[2 * i] : ps[2 * i + 1]; q1[i] = keep + shx(send, 1); }
#pragma unroll
            for (int i = 0; i < 2; ++i) { const bool o = lane & 2; const float keep = o ? q1[2 * i + 1] : q1[2 * i], send = o ? q1[2 * i] : q1[2 * i + 1]; q2[i] = keep + shx(send, 2); }
            float q3; { const bool o = lane & 4; const float keep = o ? q2[1] : q2[0], send = o ? q2[0] : q2[1]; q3 = keep + shx(send, 4); }
            q3 += shx(q3, 8); q3 += shx(q3, 16); q3 += shx(q3, 32);
            if ((lane >> 3) == (j & 7)) { if (j < 8) a_lo = q3; else a_hi = q3; }
        };
        float hh[2] = {0.f, 0.f};
        loadRows(B0, UBq, 0); loadRows(B1, UBq, 1);
#pragma unroll 1
        for (int jj = 0; jj < 16; jj += 2) {
            procU(B0, jj);     if (jj + 2 < 16) loadRows(B0, UBq, jj + 2);
            procU(B1, jj + 1); if (jj + 3 < 16) loadRows(B1, UBq, jj + 3);
        }
        a_lo -= 7.5f * sumx; a_hi -= 7.5f * sumx;
        {
            const float av[2] = {a_lo * su_lo, a_hi * su_hi}; const float gv[2] = {g_lo * sv_lo, g_hi * sv_hi};
#pragma unroll
            for (int i = 0; i < 2; ++i) { const float a = av[i]; const float y = 0.7978845608028654f * (a + 0.044715f * a * a * a);
                const float th = 1.f - 2.f * fast_rcp(1.f + fast_exp(2.f * y)); hh[i] = 0.5f * a * (1.f + th) * gv[i]; }
        }
        {
            float* HE = (float*)(p.ws + OFF_HE) + tok * 128; int* EI = (int*)(p.ws + OFF_EI) + tok * 128;
            HE[lane] = hh[0]; HE[64 + lane] = hh[1]; EI[lane] = e_lo; EI[64 + lane] = e_hi;
        }
    }
    }
    __syncthreads();
}


DI void peer_unit_B(const Params& p, int unit) {
    const int t0 = unit * 32; const int tid = threadIdx.x, lane = tid & 63, wid = tid >> 6;
    const bf16_t* XN = (const bf16_t*)(p.ws + OFF_HN); const unsigned char* VBq = p.ws + OFF_VB;
    const float* HEb = (const float*)(p.ws + OFF_HE); const int* EIb = (const int*)(p.ws + OFF_EI);
    int e_lo = EIb[((size_t)t0 + 4 * wid) * 128 + lane], e_hi = EIb[((size_t)t0 + 4 * wid) * 128 + 64 + lane];
    float h_lo = HEb[((size_t)t0 + 4 * wid) * 128 + lane], h_hi = HEb[((size_t)t0 + 4 * wid) * 128 + 64 + lane];
    u32x4 B0[8], B1[8], B2[8];
    auto loadRows = [&](u32x4 (&buf)[8], int j, int elo, int ehi) {
        const int esrc = j < 8 ? elo : ehi;
#pragma unroll
        for (int i = 0; i < 8; ++i) { const int eid = __builtin_amdgcn_readlane(esrc, (j & 7) * 8 + i); buf[i] = *(const u32x4*)(VBq + (size_t)eid * 1024 + 16 * lane); }
    };
    loadRows(B0, 0, e_lo, e_hi); loadRows(B1, 1, e_lo, e_hi); loadRows(B2, 2, e_lo, e_hi);
    for (int q = 0; q < 4; ++q) {
        const size_t tok = (size_t)t0 + 4 * wid + q; const size_t tn = (q < 3) ? tok + 1 : tok;
        const int ne_lo = EIb[tn * 128 + lane], ne_hi = EIb[tn * 128 + 64 + lane]; const float nh_lo = HEb[tn * 128 + lane], nh_hi = HEb[tn * 128 + 64 + lane];
        f32x2 acc[16];
#pragma unroll
        for (int i = 0; i < 16; ++i) acc[i] = (f32x2){0.f, 0.f};
        auto procV = [&](const u32x4 (&buf)[8], int j) {
            const float hsrc = j < 8 ? h_lo : h_hi;
#pragma unroll
            for (int i = 0; i < 8; ++i) {
                const float hv = __int_as_float(__builtin_amdgcn_readlane(__float_as_int(hsrc), (j & 7) * 8 + i));
                const f32x2 hv2 = {hv, hv}; const u32x4 vv = buf[i];
#pragma unroll
                for (int d = 0; d < 4; ++d) { const unsigned wv = vv[d];
                    acc[4 * d + 0] += hv2 * __builtin_amdgcn_cvt_scalef32_pk_f32_fp4(wv, 1.0f, 0); acc[4 * d + 1] += hv2 * __builtin_amdgcn_cvt_scalef32_pk_f32_fp4(wv, 1.0f, 1);
                    acc[4 * d + 2] += hv2 * __builtin_amdgcn_cvt_scalef32_pk_f32_fp4(wv, 1.0f, 2); acc[4 * d + 3] += hv2 * __builtin_amdgcn_cvt_scalef32_pk_f32_fp4(wv, 1.0f, 3); }
            }
        };
#pragma unroll 1
        for (int jj = 0; jj < 15; jj += 3) {
            procV(B0, jj);     if (jj + 3 < 16) loadRows(B0, jj + 3, e_lo, e_hi);
            procV(B1, jj + 1); if (jj + 4 < 16) loadRows(B1, jj + 4, e_lo, e_hi); else if (q < 3) loadRows(B1, 1, ne_lo, ne_hi);
            procV(B2, jj + 2); if (jj + 5 < 16) loadRows(B2, jj + 5, e_lo, e_hi); else if (q < 3) loadRows(B2, 2, ne_lo, ne_hi);
        }
        procV(B0, 15); if (q < 3) loadRows(B0, 0, ne_lo, ne_hi);
        float* orow = p.out + tok * D + 4 * lane; const bf16_t* hrow = XN + tok * D + 4 * lane;
#pragma unroll
        for (int i = 0; i < 8; ++i) { const u32x2 hw = *(const u32x2*)(hrow + 256 * i); f32x4 a;
            a[0] = bf_lo(hw.x) + acc[2 * i][0]; a[1] = bf_hi(hw.x) + acc[2 * i][1]; a[2] = bf_lo(hw.y) + acc[2 * i + 1][0]; a[3] = bf_hi(hw.y) + acc[2 * i + 1][1];
            __builtin_nontemporal_store(a, (f32x4*)(orow + 256 * i)); }
        e_lo = ne_lo; e_hi = ne_hi; h_lo = nh_lo; h_hi = nh_hi;
    }
}

#define XB_TMO      128
#define XB_XCNT(j)  (256  + 64 * (j))
#define XB_XSUB(j)  (1280 + 64 * (j))
#define XB_XGEN(j)  (2304 + 64 * (j))
#define XB_TOP      3328
#define XB_TOPGEN   3392
#define XCD_BAR_WORDS 3456
#define XB_SPIN_CAP (1u << 20)
DI unsigned xb_ld(unsigned* p)              { return __hip_atomic_load(p, __ATOMIC_RELAXED, __HIP_MEMORY_SCOPE_AGENT); }
DI unsigned xb_add(unsigned* p, unsigned v) { return __hip_atomic_fetch_add(p, v, __ATOMIC_RELAXED, __HIP_MEMORY_SCOPE_AGENT); }
DI unsigned xb_xcc_id() { return (unsigned)__builtin_amdgcn_s_getreg((3 << 11) | 20) & 0xFu; }
#define XB_SPIN(cond, bar) do { unsigned _sp = 0; while (cond) { __builtin_amdgcn_s_sleep(1); \
    if ((++_sp & 255u) == 0u) { if (xb_ld(&(bar)[XB_TMO])) break; if (_sp > XB_SPIN_CAP) { atomicAdd(&(bar)[XB_TMO], 1u); break; } } } } while (0)
struct XcdBarrier { unsigned* bar; unsigned x; volatile LAS unsigned* st; };
DI XcdBarrier xcd_barrier_post(unsigned* bar, volatile LAS unsigned* st) {
    XcdBarrier b; b.bar = bar; b.x = xb_xcc_id(); b.st = st;
    if (threadIdx.x == 0) (void)xb_add(&bar[XB_XCNT(b.x)], 1u);
    return b;
}
DI void xcd_barrier_complete(unsigned* bar, unsigned x, unsigned& nloc, unsigned& nx) {
    const unsigned G = gridDim.x * gridDim.y * gridDim.z;
    unsigned sum, cnt, mine, sp = 0u;
    for (;;) {
        sum = 0u; cnt = 0u; mine = 0u;
#pragma unroll
        for (unsigned j = 0; j < 16; ++j) { const unsigned c = xb_ld(&bar[XB_XCNT(j)]); sum += c; cnt += (c > 0u) ? 1u : 0u; mine = (j == x) ? c : mine; }
        if (sum == G) break;
        __builtin_amdgcn_s_sleep(1);
        if ((++sp & 255u) == 0u) { if (xb_ld(&bar[XB_TMO])) break; if (sp > XB_SPIN_CAP) { atomicAdd(&bar[XB_TMO], 1u); break; } }
    }
    nloc = mine > 0u ? mine : 1u; nx = cnt > 0u ? cnt : 1u;
}
DI void xcd_barrier(const XcdBarrier& b) {
    asm volatile("s_waitcnt vmcnt(0)" ::: "memory");
    __syncthreads();
    if (threadIdx.x == 0) {
        unsigned* bar = b.bar;
        __builtin_amdgcn_s_waitcnt(0);
        unsigned nloc = b.st[0], nx = b.st[1];
        if (nloc == 0u) { xcd_barrier_complete(bar, b.x, nloc, nx); b.st[0] = nloc; b.st[1] = nx; }
        const unsigned old = xb_add(&bar[XB_XSUB(b.x)], 1u);
        const unsigned gen = old / nloc;
        if (old + 1u == (gen + 1u) * nloc) {
            __builtin_amdgcn_fence(__ATOMIC_RELEASE, "agent");
            asm volatile("s_waitcnt vmcnt(0)" ::: "memory");
            const unsigned og = xb_add(&bar[XB_TOP], 1u);
            const unsigned tg = og / nx;
            if (og + 1u == (tg + 1u) * nx) xb_add(&bar[XB_TOPGEN], 1u);
            else XB_SPIN(xb_ld(&bar[XB_TOPGEN]) == tg, bar);
            __builtin_amdgcn_fence(__ATOMIC_ACQUIRE, "agent");
            xb_add(&bar[XB_XGEN(b.x)], 1u);
            asm volatile("s_waitcnt vmcnt(0)" ::: "memory");
        } else {
            XB_SPIN(xb_ld(&bar[XB_XGEN(b.x)]) == gen, bar);
            __builtin_amdgcn_fence(__ATOMIC_ACQUIRE, "agent");
            asm volatile("s_waitcnt vmcnt(0)" ::: "memory");
        }
    }
    __syncthreads();
}

template <int MODE>
__global__ __launch_bounds__(512, 2) void fwd_kernel(Params p) {
    extern __shared__ __attribute__((aligned(16))) unsigned char shm[];
    const int bid = blockIdx.x, nb = gridDim.x;
    XcdBarrier xb{};
    if constexpr (MODE < 0) {
        volatile LAS unsigned* st = (volatile LAS unsigned*)((LAS unsigned char*)shm + (DYN_LDS - 16));
        if (threadIdx.x == 0) { st[0] = 0u; st[1] = 0u; }
        __syncthreads();
        xb = xcd_barrier_post((unsigned*)(p.ws + OFF_XBAR), st);
    }
    if constexpr (MODE < 0 || MODE == 0) phase0(p, shm, bid, nb, 0);
    if constexpr (MODE < 0) { if (p.ws == nullptr) cg::this_grid().sync();
        xcd_barrier(xb); }
    if constexpr (MODE < 0 || MODE == 1) {
        pg8::StaticOrder S; S.init(MROWS, INC, nb, bid);
        pg8::EpiBf16 E{(bf16_t*)(p.ws + OFF_PROJ), INC, 1};
        pg8::gemm_phase((LAS unsigned char*)shm, pg8::Gemm{(const bf16_t*)(p.ws + OFF_HN), (const bf16_t*)(p.ws + OFF_WINT), MROWS, INC, D}, S, E);
    }
#if REP == 1
    if constexpr (MODE < 0) { __syncthreads();
        pg8::StaticOrder S; S.init(MROWS, INC, nb, bid);
        pg8::EpiBf16 E{(bf16_t*)(p.ws + OFF_PROJ), INC, 1};
        pg8::gemm_phase((LAS unsigned char*)shm, pg8::Gemm{(const bf16_t*)(p.ws + OFF_HN), (const bf16_t*)(p.ws + OFF_WINT), MROWS, INC, D}, S, E); }
#endif
    if constexpr (MODE < 0) xcd_barrier(xb);
    if constexpr (MODE < 0 || MODE == 2) {
        if (nb >= 128) { if (bid < 64) hgrn_item(p, shm, bid); else { for (int it = bid - 64; it < 256; it += nb - 64) attn_item(p, shm, it); phase0(p, shm, bid - 64, nb - 64, 1); } }
        else { for (int it = bid; it < 64; it += nb) hgrn_item(p, shm, it); for (int it = bid; it < 256; it += nb) attn_item(p, shm, it); phase0(p, shm, bid, nb, 1); }
    }
#if REP == 2
    if constexpr (MODE < 0) { __syncthreads(); if (bid < 64) hgrn_item(p, shm, bid); else for (int it = bid - 64; it < 256; it += nb - 64) attn_item(p, shm, it); }
#endif
    if constexpr (MODE < 0) xcd_barrier(xb);
    if constexpr (MODE < 0 || MODE == 3) {
        pg8::StaticOrder S; S.init(T, D, nb, bid);
        pg8::EpiBf16Res E{(bf16_t*)(p.ws + OFF_HN), p.x, D};
        pg8::gemm_phase((LAS unsigned char*)shm, pg8::Gemm{(const bf16_t*)(p.ws + OFF_MIX), (const bf16_t*)(p.ws + OFF_WOUTT), T, D, D}, S, E);
    }
    if constexpr (MODE < 0) xcd_barrier(xb);
    if constexpr (MODE < 0 || MODE == 5) {
        pg8::StaticOrder S; S.init(T, D, nb, bid);
        pg8::EpiBf16 E{(bf16_t*)(p.ws + OFF_PROJ), D, 0};
        pg8::gemm_phase((LAS unsigned char*)shm, pg8::Gemm{(const bf16_t*)(p.ws + OFF_HN), (const bf16_t*)(p.ws + OFF_WQT), T, D, D}, S, E);
    }
    if constexpr (MODE < 0) xcd_barrier(xb);
#if REP == 6
    if constexpr (MODE < 0) { for (int u = bid; u < T / 32; u += nb) peer_unit(p, shm, u, true); }
#endif
    if constexpr (MODE < 0 || MODE == 6) {
        if (nb == 256 && ((bid >> 3) & 1)) {
            peer_unit(p, shm, bid, 1); peer_unit(p, shm + 51200, bid + nb, 1); peer_unit(p, shm, bid, 2); peer_unit(p, shm + 51200, bid + nb, 2);
        } else { for (int u = bid; u < T / 32; u += nb) peer_unit(p, shm, u); }
    }
    if constexpr (MODE < 0 || MODE == 6) { for (int u = bid; u < T / 32; u += nb) peer_unit_B(p, u); }
}

template <int MODE> static void launch_plain(const Params& p, int grid, hipStream_t stream) {
    hipFuncSetAttribute((const void*)fwd_kernel<MODE>, hipFuncAttributeMaxDynamicSharedMemorySize, DYN_LDS);
    hipLaunchKernelGGL((fwd_kernel<MODE>), dim3(grid), dim3(512), DYN_LDS, stream, p);
}

extern "C" void kernel_launch(void* const* d_in, const int* in_sizes, int n_in, void* d_out, int out_size, void* d_ws, size_t ws_size, hipStream_t stream) {
    if (ws_size < WS_NEED) { fprintf(stderr, "workspace too small: %zu < %zu\n", ws_size, WS_NEED); return; }
    Params p{};
    p.x = (const float*)d_in[0]; p.meta = (const float*)d_in[1]; p.lb_logits = (const float*)d_in[2]; p.ln_mix_g = (const float*)d_in[3]; p.w_in = (const float*)d_in[4];
    p.q_norm_g = (const float*)d_in[5]; p.k_norm_g = (const float*)d_in[6]; p.sinks = (const float*)d_in[7]; p.hgrn_norm_g = (const float*)d_in[8]; p.w_out = (const float*)d_in[9];
    p.ln_ffn_g = (const float*)d_in[10]; p.peer_wq = (const float*)d_in[11]; p.sub_keys = (const float*)d_in[12]; p.peer_u = (const float*)d_in[13]; p.peer_v = (const float*)d_in[14];
    p.out = (float*)d_out; p.ws = (unsigned char*)d_ws;
#if MK_SINGLE
    static int grid_blocks = 0;
    if (!grid_blocks) {
        hipFuncSetAttribute((const void*)fwd_kernel<-1>, hipFuncAttributeMaxDynamicSharedMemorySize, DYN_LDS);
        int dev = 0, cus = 0, per_cu = 0; hipGetDevice(&dev); hipDeviceGetAttribute(&cus, hipDeviceAttributeMultiprocessorCount, dev);
        hipOccupancyMaxActiveBlocksPerMultiprocessor(&per_cu, fwd_kernel<-1>, 512, DYN_LDS);
        if (per_cu > 1) per_cu = 1;
        grid_blocks = cus * per_cu;
    }
    hipMemsetAsync((char*)d_ws + OFF_XBAR, 0, XCD_BAR_WORDS * 4, stream);
    void* args[] = {&p};
    hipError_t e = hipLaunchCooperativeKernel((void*)fwd_kernel<-1>, dim3(grid_blocks), dim3(512), args, DYN_LDS, stream);
    if (e != hipSuccess) fprintf(stderr, "cooperative launch failed: %s (grid %d)\n", hipGetErrorString(e), grid_blocks);
#else
    launch_plain<0>(p, 256, stream); launch_plain<1>(p, 256, stream); launch_plain<2>(p, 256, stream); launch_plain<3>(p, 256, stream);
    launch_plain<4>(p, 256, stream); launch_plain<5>(p, 256, stream); launch_plain<6>(p, 256, stream);
#endif
}
```

```cpp
#include <hip/hip_runtime.h>
#include <hip/hip_cooperative_groups.h>
#include <cstdio>
namespace cg = cooperative_groups;

#ifndef REP
#define REP 0
#endif
#ifndef MK_SINGLE
#define MK_SINGLE 1
#endif

#define LAS __attribute__((address_space(3)))
#define DI __device__ __forceinline__
typedef unsigned short bf16_t;
typedef short bf16x8 __attribute__((ext_vector_type(8)));
typedef short s16x4 __attribute__((ext_vector_type(4)));
typedef float f32x4 __attribute__((ext_vector_type(4)));
typedef float f32x16 __attribute__((ext_vector_type(16)));
typedef unsigned u32x4 __attribute__((ext_vector_type(4)));
typedef unsigned u32x2 __attribute__((ext_vector_type(2)));
typedef __bf16 bf16x2_t __attribute__((ext_vector_type(2)));
typedef float f32x2 __attribute__((ext_vector_type(2)));

constexpr int D = 2048, SEQ = 2048, T = 16384, NMETA = 16, MROWS = 16640, INC = 5632;
constexpr int COL_K = 1024, COL_V = 1280, COL_HQ = 1536, COL_HF = 2560, COL_HI = 3584, COL_HG = 4608;
constexpr float RMS_EPS = 1e-6f;
constexpr float LOG2E = 1.4426950408889634f;

constexpr size_t OFF_WINT = 0;
constexpr size_t OFF_WOUTT = OFF_WINT + (size_t)INC * D * 2;
constexpr size_t OFF_WQT = OFF_WOUTT + (size_t)D * D * 2;
constexpr size_t OFF_HN = OFF_WQT + (size_t)D * D * 2;
constexpr size_t OFF_PROJ = OFF_HN + (size_t)MROWS * D * 2;
constexpr size_t OFF_MIX = OFF_PROJ + (size_t)MROWS * INC * 2;
constexpr size_t OFF_UB = OFF_MIX + (size_t)T * D * 2;
constexpr size_t OFF_VB = OFF_UB + (size_t)16384 * D * 2;
constexpr size_t OFF_SK = OFF_VB + (size_t)16384 * D * 2;
constexpr size_t OFF_ROPE = OFF_SK + (size_t)262144 * 2;
constexpr size_t OFF_LB = OFF_ROPE + (size_t)2064 * 32 * 4;
constexpr size_t OFF_SU = OFF_LB + 4096;
constexpr size_t OFF_SV = OFF_SU + 65536;
constexpr size_t OFF_XBAR = OFF_SV + 65536;
constexpr size_t OFF_HE = OFF_XBAR + 16384;
constexpr size_t OFF_EI = OFF_HE + (size_t)T * 128 * 4;
constexpr size_t WS_NEED = OFF_EI + (size_t)T * 128 * 4;
constexpr int DYN_LDS = 155648;

struct Params {
    const float *x, *meta, *lb_logits, *ln_mix_g, *w_in, *q_norm_g, *k_norm_g, *sinks, *hgrn_norm_g, *w_out, *ln_ffn_g, *peer_wq, *sub_keys, *peer_u, *peer_v;
    float* out;
    unsigned char* ws;
};

DI unsigned pk2(float a, float b) { f32x2 v = {a, b}; bf16x2_t r = __builtin_convertvector(v, bf16x2_t); return __builtin_bit_cast(unsigned, r); }
DI bf16_t f2bf(float a) { return (bf16_t)(pk2(a, 0.f) & 0xffffu); }
DI float bf_lo(unsigned u) { return __uint_as_float(u << 16); }
DI float bf_hi(unsigned u) { return __uint_as_float(u & 0xffff0000u); }
DI float bf2f(bf16_t h) { return __uint_as_float(((unsigned)h) << 16); }
DI float shx(float v, int m) { return __shfl_xor(v, m, 64); }
DI int shxi(int v, int m) { return __shfl_xor(v, m, 64); }
DI float fast_exp(float x) { return __builtin_amdgcn_exp2f(x * LOG2E); }
DI float fast_rcp(float x) { return __builtin_amdgcn_rcpf(x); }
DI float dot2u(unsigned w, unsigned x, float acc) { return __builtin_amdgcn_fdot2_f32_bf16(__builtin_bit_cast(bf16x2_t, w), __builtin_bit_cast(bf16x2_t, x), acc, false); }
DI f32x16 mfma32(bf16x8 a, bf16x8 b, f32x16 c) { return __builtin_amdgcn_mfma_f32_32x32x16_bf16(a, b, c, 0, 0, 0); }
DI f32x4 mfma16(bf16x8 a, bf16x8 b, f32x4 c) { return __builtin_amdgcn_mfma_f32_16x16x32_bf16(a, b, c, 0, 0, 0); }
DI bf16x8 pack8(const float* f) { u32x4 w; w.x = pk2(f[0], f[1]); w.y = pk2(f[2], f[3]); w.z = pk2(f[4], f[5]); w.w = pk2(f[6], f[7]); return __builtin_bit_cast(bf16x8, w); }
DI void unpack8(u32x4 w, float* f) { f[0] = bf_lo(w.x); f[1] = bf_hi(w.x); f[2] = bf_lo(w.y); f[3] = bf_hi(w.y); f[4] = bf_lo(w.z); f[5] = bf_hi(w.z); f[6] = bf_lo(w.w); f[7] = bf_hi(w.w); }

namespace pg8 {
constexpr int BM = 256, BK = 64, HALF = 128, HTB = HALF * BK * 2, STAGE_BYTES = 8 * HTB, NXCD = 8, WGM = 8;
DI int lds_byte(int r, int c) { const int st = (r >> 4) * 2 + (c >> 5), rr = r & 15, cc = c & 31, ob = rr * 64 + cc * 2; return st * 1024 + (ob ^ (((ob >> 9) & 1) << 5)); }
DI void stage_rc(int b, int& R, int& C) { const int st = b / 1024, sb = b % 1024, swz = sb ^ (((sb >> 9) & 1) << 5); R = (st >> 1) * 16 + swz / 64; C = (st & 1) * 32 + (swz % 64) / 2; }
DI int perm32(int rho) { const int n = rho >> 4, i = rho & 15; return 8 * (i >> 2) + 4 * n + (i & 3); }
struct Unit { int pm, pn; };
struct Gemm { const bf16_t* A; const bf16_t* Bt; int M, N, K; };
struct StaticOrder {
    int nM, nN, nwg, G, c;
    DI void init(int M, int N, int G_, int c_) { nM = M / BM; nN = N / BM; nwg = nM * nN; G = G_; c = c_; }
    DI bool next(int i, Unit& u) const {
        const long L = (long)i * G + c; if (L >= nwg) return false;
        int wgid = (int)L; { const int q = nwg / NXCD, r = nwg % NXCD, xcd = wgid % NXCD, off = wgid / NXCD; wgid = (xcd < r ? xcd * (q + 1) : r * (q + 1) + (xcd - r) * q) + off; }
        const int nig = WGM * nN, gid = wgid / nig, fm = gid * WGM, gsz = (nM - fm) < WGM ? (nM - fm) : WGM;
        u.pm = fm + ((wgid % nig) % gsz); u.pn = (wgid % nig) / gsz; return true;
    }
};
struct EpiBf16 {
    static constexpr bool PERM = true;
    bf16_t* O; int ldc; int acts;
    DI void operator()(const f32x4 (&acc)[2][2][4][2], const Unit& u, int wr, int wc, int fr, int fq) const {
        const int row0 = u.pm * BM + wr * 64 + fr; const int col0 = u.pn * BM + wc * 32 + 8 * fq;
        const int kind = !acts ? 0 : (((u.pn >= 6 && u.pn < 10) || u.pn >= 18) ? 1 : ((u.pn >= 10 && u.pn < 14) ? 2 : 0));
#pragma unroll
        for (int ai = 0; ai < 2; ++ai)
#pragma unroll
            for (int m = 0; m < 4; ++m) { bf16_t* rowp = O + (size_t)(row0 + ai * HALF + m * 16) * ldc + col0;
#pragma unroll
                for (int bj = 0; bj < 2; ++bj) { f32x4 v0 = acc[ai][bj][m][0], v1 = acc[ai][bj][m][1];
                    if (kind == 1) {
#pragma unroll
                        for (int j = 0; j < 4; ++j) { v0[j] = v0[j] * fast_rcp(1.f + fast_exp(-v0[j])); v1[j] = v1[j] * fast_rcp(1.f + fast_exp(-v1[j])); } }
                    else if (kind == 2) {
#pragma unroll
                        for (int j = 0; j < 4; ++j) { v0[j] = fast_rcp(1.f + fast_exp(v0[j])); v1[j] = fast_rcp(1.f + fast_exp(v1[j])); } }
                    u32x4 w; w.x = pk2(v0[0], v0[1]); w.y = pk2(v0[2], v0[3]); w.z = pk2(v1[0], v1[1]); w.w = pk2(v1[2], v1[3]);
                    *(u32x4*)(rowp + bj * HALF) = w; } }
    }
};
struct EpiBf16Res {
    static constexpr bool PERM = true;
    bf16_t* O; const float* R; int ldc;
    DI void operator()(const f32x4 (&acc)[2][2][4][2], const Unit& u, int wr, int wc, int fr, int fq) const {
        const int row0 = u.pm * BM + wr * 64 + fr; const int col0 = u.pn * BM + wc * 32 + 8 * fq;
#pragma unroll
        for (int ai = 0; ai < 2; ++ai)
#pragma unroll
            for (int m = 0; m < 4; ++m) { const size_t ro = (size_t)(row0 + ai * HALF + m * 16) * ldc + col0;
#pragma unroll
                for (int bj = 0; bj < 2; ++bj) { const f32x4 r0 = __builtin_nontemporal_load((const f32x4*)(R + ro + bj * HALF)), r1 = __builtin_nontemporal_load((const f32x4*)(R + ro + bj * HALF + 4));
                    const f32x4 v0 = acc[ai][bj][m][0] + r0, v1 = acc[ai][bj][m][1] + r1;
                    u32x4 w; w.x = pk2(v0[0], v0[1]); w.y = pk2(v0[2], v0[3]); w.z = pk2(v1[0], v1[1]); w.w = pk2(v1[2], v1[3]);
                    *(u32x4*)(O + ro + bj * HALF) = w; } }
    }
};
struct EpiF32Res {
    static constexpr bool PERM = false;
    float* C; const float* R; int ldc; bf16_t* Hb;
    DI void operator()(const f32x4 (&acc)[2][2][4][2], const Unit& u, int wr, int wc, int fr, int fq) const {
        const int row0 = u.pm * BM + wr * 64 + fr, col0 = u.pn * BM + wc * 32 + 4 * fq;
#pragma unroll
        for (int ai = 0; ai < 2; ++ai)
#pragma unroll
            for (int m = 0; m < 4; ++m) { const size_t ro = (size_t)(row0 + ai * HALF + m * 16) * ldc + col0;
#pragma unroll
                for (int bj = 0; bj < 2; ++bj)
#pragma unroll
                    for (int n = 0; n < 2; ++n) { const f32x4 rv = *(const f32x4*)(R + ro + bj * HALF + n * 16); const f32x4 hv = acc[ai][bj][m][n] + rv; if (C) *(f32x4*)(C + ro + bj * HALF + n * 16) = hv;
                        u32x2 hb; hb.x = pk2(hv[0], hv[1]); hb.y = pk2(hv[2], hv[3]); *(u32x2*)(Hb + ro + bj * HALF + n * 16) = hb; } }
    }
};

template <class Epi, class Sched>
DI void gemm_phase(LAS unsigned char* lds, const Gemm g, const Sched& S, const Epi& E) {
    const int tid = threadIdx.x, wid = __builtin_amdgcn_readfirstlane(tid >> 6), lane = tid & 63, wr = wid >> 2, wc = wid & 3, fr = lane & 15, fq = lane >> 4;
    const int K = g.K, nt = K / BK;
    unsigned voffA[2], voffB[2];
#pragma unroll
    for (int i = 0; i < 2; ++i) { int R, C; stage_rc(tid * 16 + i * 8192, R, C); const int Rb = Epi::PERM ? ((R & ~31) + perm32(R & 31)) : R;
        voffA[i] = (unsigned)(R * K + C) * 2u; voffB[i] = (unsigned)(Rb * K + C) * 2u; }
    const size_t kstep = (size_t)(BK * 2);
    const size_t hstep = (size_t)HALF * K * 2;
    const size_t tstep = 2 * hstep;
    const unsigned ldsw = (unsigned)wid * 1024u;
    const int aoff = lds_byte(wr * 64 + fr, fq * 8), boff = lds_byte(wc * 32 + fr, fq * 8);
#define PG8_SA(b, h) (((b) * 2 + (h)) * HTB)
#define PG8_SB(b, h) ((4 + (b) * 2 + (h)) * HTB)
#define PG8_STAGE(bufoff, gbase, voff) do { _Pragma("unroll") for (int _i = 0; _i < 2; ++_i) \
        __builtin_amdgcn_global_load_lds((const unsigned*)((const char*)(gbase) + (voff)[_i]), (LAS unsigned*)(lds + (bufoff) + ldsw + _i * 8192), 16, 0, 0); } while (0)
#define PG8_LDA(dst, b, h) do { _Pragma("unroll") for (int m = 0; m < 4; ++m) _Pragma("unroll") for (int k = 0; k < 2; ++k) dst[m][k] = *(const LAS bf16x8*)(lds + PG8_SA(b, h) + aoff + m * 2048 + k * 1024); } while (0)
#define PG8_LDB(dst, b, h) do { _Pragma("unroll") for (int n = 0; n < 2; ++n) _Pragma("unroll") for (int k = 0; k < 2; ++k) dst[n][k] = *(const LAS bf16x8*)(lds + PG8_SB(b, h) + boff + n * 2048 + k * 1024); } while (0)
#define PG8_MMA(ai, bj, At, Bt) do { __builtin_amdgcn_s_setprio(1); _Pragma("unroll") for (int m = 0; m < 4; ++m) _Pragma("unroll") for (int n = 0; n < 2; ++n) _Pragma("unroll") for (int k = 0; k < 2; ++k) \
        acc[ai][bj][m][n] = __builtin_amdgcn_mfma_f32_16x16x32_bf16(Bt[n][k], At[m][k], acc[ai][bj][m][n], 0, 0, 0); __builtin_amdgcn_s_setprio(0); } while (0)
#define PG8_WAIT_V(n) asm volatile("s_waitcnt vmcnt(" #n ")" ::: "memory")
#define PG8_WAIT_L(n) asm volatile("s_waitcnt lgkmcnt(" #n ")" ::: "memory")
#define PG8_BAR __builtin_amdgcn_s_barrier()
#define PG8_SCHED __builtin_amdgcn_sched_barrier(0)
    Unit cur, nxt; int ui = 0;
    if (!S.next(0, cur)) return;
    f32x4 acc[2][2][4][2];
#pragma unroll
    for (int a = 0; a < 2; ++a)
#pragma unroll
        for (int b = 0; b < 2; ++b)
#pragma unroll
            for (int m = 0; m < 4; ++m)
#pragma unroll
                for (int n = 0; n < 2; ++n) acc[a][b][m][n] = (f32x4){0.f, 0.f, 0.f, 0.f};
    bf16x8 At[4][2], B0[2][2], B1[2][2];
    const char* cA = (const char*)g.A + (size_t)cur.pm * tstep; const char* cB = (const char*)g.Bt + (size_t)cur.pn * tstep;
    PG8_STAGE(PG8_SB(0, 0), cB, voffB); PG8_STAGE(PG8_SA(0, 0), cA, voffA); PG8_STAGE(PG8_SB(0, 1), cB + hstep, voffB); PG8_STAGE(PG8_SA(0, 1), cA + hstep, voffA);
    if (wr == 1) PG8_BAR;
    PG8_WAIT_V(4); PG8_BAR;
    PG8_STAGE(PG8_SB(1, 0), cB + kstep, voffB); PG8_STAGE(PG8_SA(1, 0), cA + kstep, voffA); PG8_STAGE(PG8_SB(1, 1), cB + hstep + kstep, voffB);
    PG8_WAIT_V(6); PG8_BAR;
    for (;;) {
        const bool has_next = S.next(ui + 1, nxt);
        const char* nA = has_next ? (const char*)g.A + (size_t)nxt.pm * tstep : cA; const char* nB = has_next ? (const char*)g.Bt + (size_t)nxt.pn * tstep : cB;
        for (int t = 0; t < nt; t += 2) {
            const bool last = (t == nt - 2);
            const char* a1 = cA + (size_t)(t + 1) * kstep;
            const char* a2 = last ? nA : cA + (size_t)(t + 2) * kstep; const char* b2 = last ? nB : cB + (size_t)(t + 2) * kstep;
            const char* a3 = a2 + kstep; const char* b3 = b2 + kstep;
            PG8_LDB(B0, 0, 0); PG8_SCHED; PG8_LDA(At, 0, 0); PG8_STAGE(PG8_SA(1, 1), a1 + hstep, voffA);
            PG8_WAIT_L(8); PG8_BAR; PG8_WAIT_L(0); PG8_MMA(0, 0, At, B0); PG8_BAR; PG8_SCHED;
            PG8_LDB(B1, 0, 1); PG8_STAGE(PG8_SB(0, 0), b2, voffB);
            PG8_BAR; PG8_WAIT_L(0); PG8_MMA(0, 1, At, B1); PG8_BAR;
            PG8_LDA(At, 0, 1); PG8_STAGE(PG8_SA(0, 0), a2, voffA);
            PG8_BAR; PG8_WAIT_L(0); PG8_MMA(1, 0, At, B0); PG8_BAR; PG8_SCHED;
            PG8_STAGE(PG8_SB(0, 1), b2 + hstep, voffB);
            PG8_WAIT_V(6); PG8_BAR; PG8_MMA(1, 1, At, B1); PG8_BAR;
            PG8_LDB(B0, 1, 0); PG8_SCHED; PG8_LDA(At, 1, 0); PG8_STAGE(PG8_SA(0, 1), a2 + hstep, voffA);
            PG8_WAIT_L(8); PG8_BAR; PG8_WAIT_L(0); PG8_MMA(0, 0, At, B0); PG8_BAR; PG8_SCHED;
            PG8_LDB(B1, 1, 1); PG8_STAGE(PG8_SB(1, 0), b3, voffB);
            PG8_BAR; PG8_WAIT_L(0); PG8_MMA(0, 1, At, B1); PG8_BAR;
            PG8_LDA(At, 1, 1); PG8_STAGE(PG8_SA(1, 0), a3, voffA);
            PG8_BAR; PG8_WAIT_L(0); PG8_MMA(1, 0, At, B0); PG8_BAR; PG8_SCHED;
            PG8_STAGE(PG8_SB(1, 1), b3 + hstep, voffB);
            PG8_WAIT_V(6); PG8_BAR; PG8_MMA(1, 1, At, B1); PG8_BAR;
        }
        E(acc, cur, wr, wc, fr, fq);
        if (!has_next) break;
#pragma unroll
        for (int a = 0; a < 2; ++a)
#pragma unroll
            for (int b = 0; b < 2; ++b)
#pragma unroll
                for (int m = 0; m < 4; ++m)
#pragma unroll
                    for (int n = 0; n < 2; ++n) acc[a][b][m][n] = (f32x4){0.f, 0.f, 0.f, 0.f};
        cur = nxt; cA = nA; cB = nB; ++ui;
    }
    PG8_WAIT_V(0);
    if (wr == 0) PG8_BAR;
    PG8_BAR;
#undef PG8_SA
#undef PG8_SB
#undef PG8_STAGE
#undef PG8_LDA
#undef PG8_LDB
#undef PG8_MMA
#undef PG8_WAIT_V
#undef PG8_WAIT_L
#undef PG8_BAR
#undef PG8_SCHED
}
}

DI void rms_row(const float* src, const float* g, bf16_t* dst, int lane) {
    f32x4 v[8]; float ss = 0.f;
#pragma unroll
    for (int i = 0; i < 4; ++i) { v[2 * i] = *(const f32x4*)(src + 512 * i + 8 * lane); v[2 * i + 1] = *(const f32x4*)(src + 512 * i + 8 * lane + 4); }
#pragma unroll
    for (int i = 0; i < 8; ++i) ss += v[i][0] * v[i][0] + v[i][1] * v[i][1] + v[i][2] * v[i][2] + v[i][3] * v[i][3];
#pragma unroll
    for (int m = 1; m < 64; m <<= 1) ss += shx(ss, m);
    const float rs = __builtin_amdgcn_rsqf(ss * (1.f / 2048.f) + RMS_EPS);
#pragma unroll
    for (int i = 0; i < 4; ++i) {
        const f32x4 g0 = *(const f32x4*)(g + 512 * i + 8 * lane), g1 = *(const f32x4*)(g + 512 * i + 8 * lane + 4);
        const f32x4 a = v[2 * i] * rs * g0, b = v[2 * i + 1] * rs * g1;
        u32x4 w; w.x = pk2(a[0], a[1]); w.y = pk2(a[2], a[3]); w.z = pk2(b[0], b[1]); w.w = pk2(b[2], b[3]);
        *(u32x4*)(dst + 512 * i + 8 * lane) = w;
    }
}

DI void phase0(const Params& p, unsigned char* lds, int bid, int nb, const int part) {
    const int tid = threadIdx.x, lane = tid & 63, wid = tid >> 6;
    float* tile = (float*)lds;
    constexpr int U_IN = 32 * 22, U_SQ = 32 * 8;
    for (int u = bid + (part ? U_IN : 0); u < (part ? U_IN + 2 * U_SQ : U_IN); u += nb) {
        const float* W; bf16_t* Wt; int N; int uu = u;
        if (uu < U_IN) { W = p.w_in; Wt = (bf16_t*)(p.ws + OFF_WINT); N = INC; }
        else if (uu < U_IN + U_SQ) { uu -= U_IN; W = p.w_out; Wt = (bf16_t*)(p.ws + OFF_WOUTT); N = D; }
        else { uu -= U_IN + U_SQ; W = p.peer_wq; Wt = (bf16_t*)(p.ws + OFF_WQT); N = D; }
        const bool foldg = (u >= U_IN + U_SQ);
        const int ntl = N / 256; const int k0 = (uu / ntl) * 64, n0 = (uu % ntl) * 256;
        f32x4 tv[8];
#pragma unroll
        for (int i = 0; i < 8; ++i) tv[i] = __builtin_nontemporal_load((const f32x4*)(W + (size_t)(k0 + (tid >> 6) + 8 * i) * N + n0 + 4 * (tid & 63)));
#pragma unroll
        for (int i = 0; i < 8; ++i) *(f32x4*)(tile + ((tid >> 6) + 8 * i) * 260 + 4 * (tid & 63)) = tv[i];
        __syncthreads();
#pragma unroll
        for (int i = 0; i < 4; ++i) { const int task = tid + 512 * i, n = task >> 3, kc = task & 7; float f[8];
#pragma unroll
            for (int j = 0; j < 8; ++j) { f[j] = tile[(kc * 8 + j) * 260 + n]; if (foldg) f[j] *= p.ln_ffn_g[k0 + kc * 8 + j]; }
            *(bf16x8*)(Wt + (size_t)(n0 + n) * 2048 + k0 + kc * 8) = pack8(f); }
        __syncthreads();
    }
    bf16_t* HN = (bf16_t*)(p.ws + OFF_HN);
    if (part == 0)
    for (int u = bid; u < MROWS / 16; u += nb) {
        const int r0 = (u * 8 + wid) * 2;
        if (r0 >= T + NMETA) { const u32x4 z = {0u, 0u, 0u, 0u};
#pragma unroll
            for (int rr = 0; rr < 2; ++rr)
#pragma unroll
                for (int i = 0; i < 4; ++i) *(u32x4*)(HN + (size_t)(r0 + rr) * D + 512 * i + 8 * lane) = z; }
        else {
            const float* s0 = r0 < T ? p.x + (size_t)r0 * D : p.meta + (size_t)(r0 - T) * D; const float* s1 = s0 + D;
            f32x4 va[8], vb[8];
#pragma unroll
            for (int i = 0; i < 8; ++i) { va[i] = __builtin_nontemporal_load((const f32x4*)(s0 + 256 * i + 4 * lane)); vb[i] = __builtin_nontemporal_load((const f32x4*)(s1 + 256 * i + 4 * lane)); }
            float sa = 0.f, sb = 0.f;
#pragma unroll
            for (int i = 0; i < 8; ++i) { sa += va[i][0] * va[i][0] + va[i][1] * va[i][1] + va[i][2] * va[i][2] + va[i][3] * va[i][3]; sb += vb[i][0] * vb[i][0] + vb[i][1] * vb[i][1] + vb[i][2] * vb[i][2] + vb[i][3] * vb[i][3]; }
#pragma unroll
            for (int m = 1; m < 64; m <<= 1) { sa += shx(sa, m); sb += shx(sb, m); }
            const float ra = __builtin_amdgcn_rsqf(sa * (1.f / 2048.f) + RMS_EPS), rb = __builtin_amdgcn_rsqf(sb * (1.f / 2048.f) + RMS_EPS);
#pragma unroll
            for (int i = 0; i < 8; ++i) {
                const f32x4 g0 = *(const f32x4*)(p.ln_mix_g + 256 * i + 4 * lane);
                { const f32x4 a = va[i] * ra * g0; u32x2 w; w.x = pk2(a[0], a[1]); w.y = pk2(a[2], a[3]); *(u32x2*)(HN + (size_t)r0 * D + 256 * i + 4 * lane) = w; }
                { const f32x4 a = vb[i] * rb * g0; u32x2 w; w.x = pk2(a[0], a[1]); w.y = pk2(a[2], a[3]); *(u32x2*)(HN + (size_t)(r0 + 1) * D + 256 * i + 4 * lane) = w; }
            }
        }
    }
    {
        unsigned char* UBq = p.ws + OFF_UB; unsigned char* VBq = p.ws + OFF_VB; float* SU = (float*)(p.ws + OFF_SU); float* SV = (float*)(p.ws + OFF_SV);
        auto quant_row = [&](f32x4 (&v)[8], const int which, const int e) {
            if (which == 0) {
                float ss = 0.f;
#pragma unroll
                for (int i = 0; i < 8; ++i) ss += v[i][0] * v[i][0] + v[i][1] * v[i][1] + v[i][2] * v[i][2] + v[i][3] * v[i][3];
#pragma unroll
                for (int m = 1; m < 64; m <<= 1) ss += shx(ss, m);
                const float step = 0.335f * __builtin_sqrtf(ss * (1.f / 2048.f)); const float inv = step > 0.f ? 1.f / step : 0.f;
                u32x4 w;
#pragma unroll
                for (int d = 0; d < 4; ++d) { const f32x4 t0 = v[2 * d] * inv + 8.f, t1 = v[2 * d + 1] * inv + 8.f; unsigned pw = 0u;
#pragma unroll
                    for (int j = 0; j < 4; ++j) { const int n0 = (int)fminf(fmaxf(floorf(t0[j]), 0.f), 15.f), n1 = (int)fminf(fmaxf(floorf(t1[j]), 0.f), 15.f); pw |= ((unsigned)n0 | ((unsigned)n1 << 4)) << (8 * j); }
                    w[d] = pw; }
                *(u32x4*)(UBq + (size_t)e * 1024 + 16 * lane) = w;
                if (lane == 0) SU[e] = step;
            } else {
                float am = 0.f;
#pragma unroll
                for (int i = 0; i < 8; ++i) am = fmaxf(fmaxf(fmaxf(am, fabsf(v[i][0])), fmaxf(fabsf(v[i][1]), fabsf(v[i][2]))), fabsf(v[i][3]));
#pragma unroll
                for (int m = 1; m < 64; m <<= 1) am = fmaxf(am, shx(am, m));
                const float sc = am > 0.f ? 6.f / am : 0.f, isc = am * (1.f / 6.f);
                u32x4 w;
#pragma unroll
                for (int d = 0; d < 4; ++d) { const f32x4 t0 = v[2 * d] * sc, t1 = v[2 * d + 1] * sc; unsigned pw = 0u;
                    pw = __builtin_amdgcn_cvt_scalef32_pk_fp4_f32(pw, t0[0], t0[1], 1.0f, 0); pw = __builtin_amdgcn_cvt_scalef32_pk_fp4_f32(pw, t0[2], t0[3], 1.0f, 1);
                    pw = __builtin_amdgcn_cvt_scalef32_pk_fp4_f32(pw, t1[0], t1[1], 1.0f, 2); pw = __builtin_amdgcn_cvt_scalef32_pk_fp4_f32(pw, t1[2], t1[3], 1.0f, 3); w[d] = pw; }
                *(u32x4*)(VBq + (size_t)e * 1024 + 16 * lane) = w;
                if (lane == 0) SV[e] = isc;
            }
        };
        if (part == 1)
        for (int u = bid; u < 2048; u += nb) {
            const int rowi = (u * 8 + wid) * 2; const int which = rowi >> 14, e = rowi & 16383;
            const float* src = (which ? p.peer_v : p.peer_u) + (size_t)e * D + 4 * lane;
            f32x4 va[8], vb[8];
#pragma unroll
            for (int i = 0; i < 8; ++i) { va[i] = *(const f32x4*)(src + 256 * i); vb[i] = *(const f32x4*)(src + D + 256 * i); }
            if (which == 0) {
#pragma unroll
                for (int i = 0; i < 8; ++i) { const f32x4 gg = *(const f32x4*)(p.ln_ffn_g + 4 * lane + 256 * i); va[i] = va[i] * gg; vb[i] = vb[i] * gg; } }
            quant_row(va, which, e); quant_row(vb, which, e + 1);
        }
    }
    if (part == 1)
    for (int u = bid; u < 64; u += nb) {
        const size_t idx = ((size_t)u * 512 + tid) * 8; const float* src = p.sub_keys + idx; bf16_t* dst = (bf16_t*)(p.ws + OFF_SK) + idx;
        const f32x4 a = *(const f32x4*)src, b = *(const f32x4*)(src + 4);
        u32x4 w; w.x = pk2(a[0], a[1]); w.y = pk2(a[2], a[3]); w.z = pk2(b[0], b[1]); w.w = pk2(b[2], b[3]);
        *(u32x4*)dst = w;
    }
    float* ROPE = (float*)(p.ws + OFF_ROPE);
    if (part == 0)
    for (int u = bid; u < 65; u += nb) {
        const int idx = u * 512 + tid;
        if (idx < 2064 * 16) { const int pos = idx >> 4, i = idx & 15;
            const float inv = exp2f(-(float)i * (18.931568569324174f / 16.f));
            const float ang = (float)pos * inv; const float rev = ang * 0.15915494309189535f; const float fr = rev - floorf(rev);
            ROPE[pos * 32 + i] = __builtin_amdgcn_cosf(fr); ROPE[pos * 32 + 16 + i] = __builtin_amdgcn_sinf(fr); }
    }
    float* LB = (float*)(p.ws + OFF_LB);
    if (part == 0)
    for (int u = bid; u < 2; u += nb) { const int k = u * 512 + tid; LB[k] = 1.f / (1.f + __expf(p.lb_logits[1024 + k] - p.lb_logits[k])); }
}

DI void phase_norm2(const Params& p, int bid, int nb) {
    const int lane = threadIdx.x & 63, wid = threadIdx.x >> 6;
    bf16_t* XN = (bf16_t*)(p.ws + OFF_HN);
    for (int u = bid; u < T / 8; u += nb) { const int r = u * 8 + wid; rms_row(p.out + (size_t)r * D, p.ln_ffn_g, XN + (size_t)r * D, lane); }
}

DI void attn_item(const Params& p, unsigned char* lds, int item) {
    const int kvh = item & 1, nbk = (item >> 1) & 15, b = item >> 5;
    const int tid = threadIdx.x, lane = tid & 63, wid = tid >> 6, h5 = lane >> 5, l31 = lane & 31;
    bf16_t* Ks = (bf16_t*)lds;
    bf16_t* Vt = (bf16_t*)(lds + 288 * 272);
    const bf16_t* proj = (const bf16_t*)(p.ws + OFF_PROJ);
    const float* ROPE = (const float*)(p.ws + OFF_ROPE);
    {
        const int sub = tid & 15, rp = tid >> 4;
        float kg[8];
#pragma unroll
        for (int j = 0; j < 8; ++j) kg[j] = p.k_norm_g[sub * 8 + j];
#pragma unroll 1
        for (int pg = 0; pg < 9; pg += 3) {
        u32x4 raws[3];
#pragma unroll
        for (int pass = pg; pass < pg + 3; ++pass) {
            const int slot = pass * 32 + rp; int row = -1;
            if (slot < 16) row = T + slot;
            else if (slot >= 32) { const int s = 128 * (nbk - 1) + (slot - 32); if (s >= 0) row = b * SEQ + s; }
            raws[pass - pg] = (u32x4){0u, 0u, 0u, 0u};
            if (row >= 0) raws[pass - pg] = *(const u32x4*)(proj + (size_t)row * INC + COL_K + kvh * 128 + sub * 8);
        }
#pragma unroll
        for (int pass = pg; pass < pg + 3; ++pass) {
            const int slot = pass * 32 + rp; int row = -1, pos = 0;
            if (slot < 16) { row = T + slot; pos = slot; }
            else if (slot >= 32) { const int s = 128 * (nbk - 1) + (slot - 32); if (s >= 0) { row = b * SEQ + s; pos = NMETA + s; } }
            const u32x4 raw = raws[pass - pg];
            float f[8]; unpack8(raw, f);
            float ss = 0.f;
#pragma unroll
            for (int j = 0; j < 8; ++j) ss += f[j] * f[j];
            ss += shx(ss, 1); ss += shx(ss, 2); ss += shx(ss, 4); ss += shx(ss, 8);
            const float rs = __builtin_amdgcn_rsqf(ss * (1.f / 128.f) + RMS_EPS);
            float pr[8];
#pragma unroll
            for (int j = 0; j < 8; ++j) { f[j] = f[j] * rs * kg[j]; pr[j] = shx(f[j], 2); }
            if (sub < 4 && row >= 0) { const float* cs = ROPE + pos * 32 + (sub & 1) * 8;
#pragma unroll
                for (int j = 0; j < 8; ++j) { const float c = cs[j], s = cs[16 + j]; f[j] = (sub < 2) ? (f[j] * c - pr[j] * s) : (f[j] * c + pr[j] * s); } }
            *(bf16x8*)(Ks + slot * 136 + sub * 8) = pack8(f);
        }
        }
    }
    {
#pragma unroll 1
        for (int ig = 0; ig < 9; ig += 3) {
        u32x4 raws[3];
#pragma unroll
        for (int it = ig; it < ig + 3; ++it) {
            const int idx = it * 512 + tid; const int key = idx % 288, dc = idx / 288; int row = -1;
            if (key < 16) row = T + key;
            else if (key >= 32) { const int s = 128 * (nbk - 1) + (key - 32); if (s >= 0) row = b * SEQ + s; }
            raws[it - ig] = (u32x4){0u, 0u, 0u, 0u};
            if (row >= 0) raws[it - ig] = *(const u32x4*)(proj + (size_t)row * INC + COL_V + kvh * 128 + dc * 8);
        }
#pragma unroll
        for (int it = ig; it < ig + 3; ++it) {
            const int idx = it * 512 + tid; const int key = idx % 288, dc = idx / 288;
            const u32x4 raw = raws[it - ig];
            bf16_t* vp = Vt + (dc * 8) * 292 + key;
            vp[0 * 292] = (bf16_t)(raw.x & 0xffffu); vp[1 * 292] = (bf16_t)(raw.x >> 16); vp[2 * 292] = (bf16_t)(raw.y & 0xffffu); vp[3 * 292] = (bf16_t)(raw.y >> 16);
            vp[4 * 292] = (bf16_t)(raw.z & 0xffffu); vp[5 * 292] = (bf16_t)(raw.z >> 16); vp[6 * 292] = (bf16_t)(raw.w & 0xffffu); vp[7 * 292] = (bf16_t)(raw.w >> 16);
        }
        }
    }
    __syncthreads();
    const int hq = kvh * 4 + (wid >> 1);
    const float sinkv = p.sinks[hq] * LOG2E;
    bf16_t* MIX = (bf16_t*)(p.ws + OFF_MIX);
#pragma unroll 1
    for (int qq = 0; qq < 2; ++qq) {
        const int qt = (wid & 1) * 2 + qq; const int iq = 32 * qt + l31; const int s = 128 * nbk + iq; const size_t row = (size_t)b * SEQ + s;
        bf16x8 qf[8];
        {
            u32x4 raw[8]; float ss = 0.f;
#pragma unroll
            for (int ks = 0; ks < 8; ++ks) { raw[ks] = *(const u32x4*)(proj + row * INC + hq * 128 + 16 * ks + 8 * h5); float f[8]; unpack8(raw[ks], f);
#pragma unroll
                for (int j = 0; j < 8; ++j) ss += f[j] * f[j]; }
            ss += shx(ss, 32);
            const float rs = __builtin_amdgcn_rsqf(ss * (1.f / 128.f) + RMS_EPS) * (0.08838834764831845f * LOG2E);
            {
                float f0[8], f1[8]; unpack8(raw[0], f0); unpack8(raw[1], f1);
                const float* cs = ROPE + (NMETA + s) * 32 + 8 * h5;
#pragma unroll
                for (int j = 0; j < 8; ++j) { const float c = cs[j], sn = cs[16 + j]; const float x1 = f0[j] * rs * p.q_norm_g[8 * h5 + j], x2 = f1[j] * rs * p.q_norm_g[16 + 8 * h5 + j];
                    f0[j] = x1 * c - x2 * sn; f1[j] = x2 * c + x1 * sn; }
                qf[0] = pack8(f0); qf[1] = pack8(f1);
            }
#pragma unroll
            for (int ks = 2; ks < 8; ++ks) { float f[8]; unpack8(raw[ks], f);
#pragma unroll
                for (int j = 0; j < 8; ++j) f[j] *= rs * p.q_norm_g[16 * ks + 8 * h5 + j];
                qf[ks] = pack8(f); }
        }
        float m = sinkv, l = 1.f;
        f32x16 O[4];
#pragma unroll
        for (int dt = 0; dt < 4; ++dt)
#pragma unroll
            for (int r = 0; r < 16; ++r) O[dt][r] = 0.f;
#pragma unroll 1
        for (int kt = -1; kt < 5; ++kt) {
            const int ktc = qt + kt; int slot0 = 0;
            if (kt >= 0) { if (nbk == 0 && ktc < 4) continue; slot0 = 32 + 32 * ktc; }
            f32x16 S;
#pragma unroll
            for (int r = 0; r < 16; ++r) S[r] = 0.f;
#pragma unroll
            for (int ks = 0; ks < 8; ++ks) { const bf16x8 kf = *(const bf16x8*)(Ks + (slot0 + l31) * 136 + 16 * ks + 8 * h5); S = mfma32(kf, qf[ks], S); }
            float tmax = -1e30f;
#pragma unroll
            for (int r = 0; r < 16; ++r) { const int kr = (r & 3) + 8 * (r >> 2) + 4 * h5; bool valid;
                if (kt < 0) valid = kr < 16; else { const int c = 32 * ktc + kr; valid = (c > iq) && (c <= 128 + iq) && (nbk > 0 || c >= 128); }
                S[r] = valid ? S[r] : -1e30f; tmax = fmaxf(tmax, S[r]); }
            tmax = fmaxf(tmax, shx(tmax, 32));
            const float mn = fmaxf(m, tmax); const float alpha = __builtin_amdgcn_exp2f(m - mn);
            float psum = 0.f;
#pragma unroll
            for (int r = 0; r < 16; ++r) { const float pv = __builtin_amdgcn_exp2f(S[r] - mn); psum += pv; S[r] = pv; }
            psum += shx(psum, 32);
            l = l * alpha + psum; m = mn;
#pragma unroll
            for (int dt = 0; dt < 4; ++dt)
#pragma unroll
                for (int r = 0; r < 16; ++r) O[dt][r] *= alpha;
#pragma unroll
            for (int sx = 0; sx < 2; ++sx) {
                float pf[8];
#pragma unroll
                for (int j = 0; j < 8; ++j) pf[j] = S[8 * sx + j];
                const bf16x8 pfr = pack8(pf);
#pragma unroll
                for (int dt = 0; dt < 4; ++dt) {
                    const bf16_t* vb = Vt + (32 * dt + l31) * 292 + slot0 + 16 * sx + 4 * h5;
                    const s16x4 lo = *(const s16x4*)vb, hi = *(const s16x4*)(vb + 8);
                    bf16x8 vf; vf[0] = lo[0]; vf[1] = lo[1]; vf[2] = lo[2]; vf[3] = lo[3]; vf[4] = hi[0]; vf[5] = hi[1]; vf[6] = hi[2]; vf[7] = hi[3];
                    O[dt] = mfma32(vf, pfr, O[dt]);
                }
            }
        }
        const float inv_l = 1.f / l;
        bf16_t* orow = MIX + row * D + hq * 128;
#pragma unroll
        for (int dt = 0; dt < 4; ++dt)
#pragma unroll
            for (int g4 = 0; g4 < 4; ++g4) { u32x2 w; w.x = pk2(O[dt][4 * g4] * inv_l, O[dt][4 * g4 + 1] * inv_l); w.y = pk2(O[dt][4 * g4 + 2] * inv_l, O[dt][4 * g4 + 3] * inv_l);
                *(u32x2*)(orow + 32 * dt + 8 * g4 + 4 * h5) = w; }
    }
    __syncthreads();
}

DI void lds_barrier() { asm volatile("s_waitcnt lgkmcnt(0)" ::: "memory"); __builtin_amdgcn_s_barrier(); asm volatile("" ::: "memory"); }
DI void hgrn_item(const Params& p, unsigned char* lds, int item) {
    const int h = item & 7, b = item >> 3;
    const int tid = threadIdx.x, lane = tid & 63, wid = tid >> 6, g = lane >> 4, l15 = lane & 15;
    bf16_t* QT = (bf16_t*)lds;
    bf16_t* KT = QT + 64 * 136;
    bf16_t* QB = KT + 64 * 136;
    bf16_t* KDT = QB + 64 * 136;
    bf16_t* VT = KDT + 128 * 72;
    bf16_t* SC = VT + 128 * 72;
    float* OL = (float*)(SC + 64 * 72);
    float* GT = OL + 64 * 132;
    float* BL = GT + 1024;
    const bf16_t* proj = (const bf16_t*)(p.ws + OFF_PROJ);
    bf16_t* MIX = (bf16_t*)(p.ws + OFF_MIX);
    const int kp = tid & 63, tg = tid >> 6;
    const float c1a = 1.f - ((const float*)(p.ws + OFF_LB))[h * 128 + 2 * kp], c1b = 1.f - ((const float*)(p.ws + OFF_LB))[h * 128 + 2 * kp + 1];
    const int vs = tid & 63, vc = tid >> 6;
    const int et = tid >> 3, eseg = tid & 7;
    float* GNL = BL + 128;
    if (tid < 128) GNL[tid] = p.hgrn_norm_g[h * 128 + tid];
    f32x4 S[8];
#pragma unroll
    for (int mt = 0; mt < 8; ++mt) S[mt] = (f32x4){0.f, 0.f, 0.f, 0.f};
    unsigned nq[8], nf[8]; u32x4 nva, nvb, nga, ngb;
    auto prefetch = [&](int c) {
#pragma unroll
        for (int i = 0; i < 8; ++i) { const int t = 8 * tg + i; int row;
            if (c == 0) row = T + max(t - 48, 0); else row = b * SEQ + 64 * (c - 1) + t;
            const bf16_t* pr = proj + (size_t)row * INC + h * 128 + 2 * kp; nf[i] = *(const unsigned*)(pr + COL_HF); nq[i] = *(const unsigned*)(pr + COL_HQ); }
        { int row; if (c == 0) row = T + max(vs - 48, 0); else row = b * SEQ + 64 * (c - 1) + vs;
          const bf16_t* pr = proj + (size_t)row * INC + COL_HI + h * 128 + 16 * vc; nva = *(const u32x4*)pr; nvb = *(const u32x4*)(pr + 8); }
        { const int cc = c > 0 ? c - 1 : 0; const bf16_t* gp = proj + ((size_t)b * SEQ + 64 * cc + et) * INC + COL_HG + h * 128 + 16 * eseg; nga = *(const u32x4*)gp; ngb = *(const u32x4*)(gp + 8); }
    };
    prefetch(0);
    for (int c = 0; c < 33; ++c) {
        unsigned cq[8], cf[8];
#pragma unroll
        for (int i = 0; i < 8; ++i) { cq[i] = nq[i]; cf[i] = nf[i]; }
        const bool vvalid = !(c == 0 && vs < 48); const u32x4 z4 = {0u, 0u, 0u, 0u};
        const u32x4 cva = vvalid ? nva : z4, cvb = vvalid ? nvb : z4, cga = nga, cgb = ngb;
        const bool padchunk = (c == 0);
        if (c < 32) prefetch(c + 1);
        {
            float bl[8][2], qs[8][2], kk[8][2]; float csa = 1.f, csb = 1.f;
#pragma unroll
            for (int i = 0; i < 8; ++i) {
                const int t = 8 * tg + i; const bool valid = !(padchunk && t < 48);
                const float ka = valid ? c1a * bf_lo(cf[i]) : 0.f, kb = valid ? c1b * bf_hi(cf[i]) : 0.f;
                csa *= (1.f - ka); csb *= (1.f - kb); bl[i][0] = csa; bl[i][1] = csb;
                qs[i][0] = valid ? bf_lo(cq[i]) : 0.f; qs[i][1] = valid ? bf_hi(cq[i]) : 0.f; kk[i][0] = ka; kk[i][1] = kb;
            }
            *(f32x2*)(GT + tg * 128 + 2 * kp) = (f32x2){csa, csb};
            {
                bf16_t* vp = VT + (16 * vc) * 72 + vs;
                vp[0 * 72] = (bf16_t)(cva.x & 0xffffu); vp[1 * 72] = (bf16_t)(cva.x >> 16); vp[2 * 72] = (bf16_t)(cva.y & 0xffffu); vp[3 * 72] = (bf16_t)(cva.y >> 16);
                vp[4 * 72] = (bf16_t)(cva.z & 0xffffu); vp[5 * 72] = (bf16_t)(cva.z >> 16); vp[6 * 72] = (bf16_t)(cva.w & 0xffffu); vp[7 * 72] = (bf16_t)(cva.w >> 16);
                vp[8 * 72] = (bf16_t)(cvb.x & 0xffffu); vp[9 * 72] = (bf16_t)(cvb.x >> 16); vp[10 * 72] = (bf16_t)(cvb.y & 0xffffu); vp[11 * 72] = (bf16_t)(cvb.y >> 16);
                vp[12 * 72] = (bf16_t)(cvb.z & 0xffffu); vp[13 * 72] = (bf16_t)(cvb.z >> 16); vp[14 * 72] = (bf16_t)(cvb.w & 0xffffu); vp[15 * 72] = (bf16_t)(cvb.w >> 16);
            }
            lds_barrier();
            f32x2 off = {1.f, 1.f}, er = {1.f, 1.f}, ebr = {1.f, 1.f};
#pragma unroll
            for (int gi = 0; gi < 8; ++gi) { const f32x2 gp = *(const f32x2*)(GT + gi * 128 + 2 * kp);
                if (gi < tg) off = off * gp;
                if (gi < 4) er = er * gp; else ebr = ebr * gp; }
            const f32x2 plast = er * ebr;
            const float iera = fast_rcp(fmaxf(er[0], 1e-30f)), ierb = fast_rcp(fmaxf(er[1], 1e-30f));
            float kda[8], kdb[8];
#pragma unroll
            for (int i = 0; i < 8; ++i) {
                const int t = 8 * tg + i; const float pta = off[0] * bl[i][0], ptb = off[1] * bl[i][1];
                const float eqa = fminf(fmaxf(pta * iera, 1e-30f), 1e30f), eqb = fminf(fmaxf(ptb * ierb, 1e-30f), 1e30f);
                const float eka = fast_rcp(eqa), ekb = fast_rcp(eqb);
                const float kea = kk[i][0] * eka, keb = kk[i][1] * ekb;
                *(unsigned*)(QT + t * 136 + 2 * kp) = pk2(qs[i][0] * eqa, qs[i][1] * eqb);
                *(unsigned*)(KT + t * 136 + 2 * kp) = pk2(kea, keb);
                *(unsigned*)(QB + t * 136 + 2 * kp) = pk2(qs[i][0] * pta, qs[i][1] * ptb);
                kda[i] = kea * ebr[0]; kdb[i] = keb * ebr[1];
            }
            *(bf16x8*)(KDT + (2 * kp) * 72 + 8 * tg) = pack8(kda); *(bf16x8*)(KDT + (2 * kp + 1) * 72 + 8 * tg) = pack8(kdb);
            if (tg == 0) *(f32x2*)(BL + 2 * kp) = plast;
        }
        lds_barrier();
#pragma unroll
        for (int q = 0; q < 2; ++q) {
            const int id = 2 * wid + q, ti = id >> 2, si = id & 3;
            f32x4 acc = {0.f, 0.f, 0.f, 0.f};
            if (si <= ti) {
#pragma unroll
                for (int ks = 0; ks < 4; ++ks) { const bf16x8 a = *(const bf16x8*)(QT + (16 * ti + l15) * 136 + 32 * ks + 8 * g); const bf16x8 bb = *(const bf16x8*)(KT + (16 * si + l15) * 136 + 32 * ks + 8 * g); acc = mfma16(a, bb, acc); }
            }
#pragma unroll
            for (int i = 0; i < 4; ++i) { const int t = 16 * ti + 4 * g + i, s = 16 * si + l15; SC[t * 72 + s] = f2bf((s <= t) ? acc[i] : 0.f); }
        }
        f32x4 oacc[4];
        {
            bf16x8 sb[4];
#pragma unroll
            for (int ks = 0; ks < 4; ++ks) { float f[8];
#pragma unroll
                for (int j = 0; j < 4; ++j) { f[j] = S[2 * ks][j]; f[4 + j] = S[2 * ks + 1][j]; }
                sb[ks] = pack8(f); }
#pragma unroll
            for (int mt = 0; mt < 4; ++mt) {
                f32x4 acc = {0.f, 0.f, 0.f, 0.f};
#pragma unroll
                for (int ks = 0; ks < 4; ++ks) { const bf16_t* qp = QB + (16 * mt + l15) * 136 + 32 * ks + 4 * g; const s16x4 lo = *(const s16x4*)qp, hi = *(const s16x4*)(qp + 16);
                    bf16x8 a; a[0] = lo[0]; a[1] = lo[1]; a[2] = lo[2]; a[3] = lo[3]; a[4] = hi[0]; a[5] = hi[1]; a[6] = hi[2]; a[7] = hi[3];
                    acc = mfma16(a, sb[ks], acc); }
                oacc[mt] = acc;
            }
#pragma unroll
            for (int mt = 0; mt < 8; ++mt) {
                const f32x4 e4 = *(const f32x4*)(BL + 16 * mt + 4 * g);
                S[mt] = S[mt] * e4;
#pragma unroll
                for (int ks = 0; ks < 2; ++ks) { const bf16x8 a = *(const bf16x8*)(KDT + (16 * mt + l15) * 72 + 32 * ks + 8 * g); const bf16x8 bv = *(const bf16x8*)(VT + (16 * wid + l15) * 72 + 32 * ks + 8 * g); S[mt] = mfma16(a, bv, S[mt]); }
            }
        }
        lds_barrier();
#pragma unroll
        for (int mt = 0; mt < 4; ++mt) {
            f32x4 acc = oacc[mt];
#pragma unroll
            for (int ks = 0; ks < 2; ++ks) { const bf16x8 a = *(const bf16x8*)(SC + (16 * mt + l15) * 72 + 32 * ks + 8 * g); const bf16x8 bv = *(const bf16x8*)(VT + (16 * wid + l15) * 72 + 32 * ks + 8 * g); acc = mfma16(a, bv, acc); }
#pragma unroll
            for (int i = 0; i < 4; ++i) OL[(16 * mt + 4 * g + i) * 132 + 16 * wid + l15] = acc[i];
        }
        lds_barrier();
        if (c > 0) {
            const size_t row = (size_t)b * SEQ + 64 * (c - 1) + et;
            float o[16]; float ss = 0.f;
#pragma unroll
            for (int i = 0; i < 4; ++i) { const f32x4 v = *(const f32x4*)(OL + et * 132 + 16 * eseg + 4 * i); o[4 * i] = v[0]; o[4 * i + 1] = v[1]; o[4 * i + 2] = v[2]; o[4 * i + 3] = v[3]; }
#pragma unroll
            for (int i = 0; i < 16; ++i) ss += o[i] * o[i];
            ss += shx(ss, 1); ss += shx(ss, 2); ss += shx(ss, 4);
            const float rs = __builtin_amdgcn_rsqf(ss * (1.f / 128.f) + RMS_EPS);
            float hg[16]; unpack8(cga, hg); unpack8(cgb, hg + 8);
            float gn[16];
#pragma unroll
            for (int i = 0; i < 4; ++i) { const f32x4 v = *(const f32x4*)(GNL + 16 * eseg + 4 * i); gn[4 * i] = v[0]; gn[4 * i + 1] = v[1]; gn[4 * i + 2] = v[2]; gn[4 * i + 3] = v[3]; }
            float outv[16];
#pragma unroll
            for (int i = 0; i < 16; ++i) outv[i] = o[i] * rs * gn[i] * hg[i];
            bf16_t* op = MIX + row * D + 1024 + h * 128 + 16 * eseg;
            *(bf16x8*)op = pack8(outv); *(bf16x8*)(op + 8) = pack8(outv + 8);
        }
    }
}

DI int sortable(float f) { const int b = __float_as_int(f); return b ^ ((b >> 31) & 0x7fffffff); }
DI float unsortable(int k) { return __int_as_float(k ^ ((k >> 31) & 0x7fffffff)); }
#define TOPK_INSERT(top, xval) do { int _x = (xval); _Pragma("unroll") for (int _j = 0; _j < 16; ++_j) { const int _hi = max((top)[_j], _x); _x = min((top)[_j], _x); (top)[_j] = _hi; } } while (0)

DI void cex_desc(int& hi, int& lo) { const int a = max(hi, lo), b = min(hi, lo); hi = a; lo = b; }
DI void bitonic_sort16_desc(int (&a)[16]) {
#pragma unroll
    for (int k = 2; k <= 16; k <<= 1)
#pragma unroll
        for (int j = k >> 1; j > 0; j >>= 1)
#pragma unroll
            for (int i = 0; i < 16; ++i) { const int l = i ^ j; if (l > i) { if ((i & k) == 0) cex_desc(a[i], a[l]); else cex_desc(a[l], a[i]); } }
}
DI void merge_top16(int (&top)[16], const int (&g)[16]) {
#pragma unroll
    for (int i = 0; i < 16; ++i) top[i] = max(top[i], g[15 - i]);
#pragma unroll
    for (int j = 8; j > 0; j >>= 1)
#pragma unroll
        for (int i = 0; i < 16; ++i) { const int l = i ^ j; if (l > i) cex_desc(top[i], top[l]); }
}
DI void peer_unit(const Params& p, unsigned char* lds, int unit, const int mode = 0) {
    const int t0 = unit * 32;
    int* SELI = (int*)lds;
    float* SELG = (float*)(lds + 16384);
    const int tid = threadIdx.x, lane = tid & 63, wid = tid >> 6, h5 = lane >> 5, l31 = lane & 31;
    const bf16_t* pq = (const bf16_t*)(p.ws + OFF_PROJ);
    const bf16_t* skb = (const bf16_t*)(p.ws + OFF_SK);
    const bf16_t* XN = (const bf16_t*)(p.ws + OFF_HN);
    const bf16_t* UB = (const bf16_t*)(p.ws + OFF_UB);
    const bf16_t* VB = (const bf16_t*)(p.ws + OFF_VB);
    float* RSL = (float*)(lds + 32768);
    if (mode != 2) {
    for (int q = 0; q < 4; ++q) {
        const int tl = 4 * wid + q; const bf16_t* xp = XN + ((size_t)t0 + tl) * D + 16 * lane; float ss = 0.f;
#pragma unroll
        for (int r = 0; r < 2; ++r) { float f[16]; unpack8(*(const u32x4*)(xp + 1024 * r), f); unpack8(*(const u32x4*)(xp + 1024 * r + 8), f + 8);
#pragma unroll
            for (int i = 0; i < 16; ++i) ss += f[i] * f[i]; }
#pragma unroll
        for (int m = 1; m < 64; m <<= 1) ss += shx(ss, m);
        if (lane == 0) RSL[tl] = __builtin_amdgcn_rsqf(ss * (1.f / 2048.f) + RMS_EPS);
    }
    __syncthreads();
    {
        const int hd = wid; const size_t tok = (size_t)t0 + l31; const float rstok = RSL[l31];
        int top0[16], top1[16];
#pragma unroll
        for (int c = 0; c < 2; ++c) {
            int top[16];
#pragma unroll
            for (int j = 0; j < 16; ++j) top[j] = (int)0x80000000;
            bf16x8 qf[8];
#pragma unroll
            for (int ks = 0; ks < 8; ++ks) qf[ks] = *(const bf16x8*)(pq + tok * D + (hd * 2 + c) * 128 + 16 * ks + 8 * h5);
            bf16x8 kf[8];
#pragma unroll
            for (int ks = 0; ks < 8; ++ks) kf[ks] = *(const bf16x8*)(skb + (size_t)((hd * 2 + c) * 128 + l31) * 128 + 16 * ks + 8 * h5);
#pragma unroll 1
            for (int mt = 0; mt < 4; ++mt) {
                bf16x8 kn[8]; const int mn = mt < 3 ? mt + 1 : mt;
#pragma unroll
                for (int ks = 0; ks < 8; ++ks) kn[ks] = *(const bf16x8*)(skb + (size_t)((hd * 2 + c) * 128 + 32 * mn + l31) * 128 + 16 * ks + 8 * h5);
                f32x16 acc;
#pragma unroll
                for (int r = 0; r < 16; ++r) acc[r] = 0.f;
#pragma unroll
                for (int ks = 0; ks < 8; ++ks) acc = mfma32(kf[ks], qf[ks], acc);
#pragma unroll
                for (int ks = 0; ks < 8; ++ks) kf[ks] = kn[ks];
                int grp[16];
#pragma unroll
                for (int r = 0; r < 16; ++r) { const int n = 32 * mt + (r & 3) + 8 * (r >> 2) + 4 * h5; grp[r] = (sortable(acc[r]) & ~127) | n; }
                bitonic_sort16_desc(grp); merge_top16(top, grp);
            }
            int other[16];
#pragma unroll
            for (int j = 0; j < 16; ++j) other[j] = shxi(top[j], 32);
            merge_top16(top, other);
#pragma unroll
            for (int j = 0; j < 16; ++j) { if (c == 0) top0[j] = top[j]; else top1[j] = top[j]; }
        }
        float v1[16], v2[16];
#pragma unroll
        for (int j = 0; j < 16; ++j) { v1[j] = unsortable(top0[j] & ~127); v2[j] = unsortable(top1[j] & ~127); }
        int c0[16], c1[16], c2[16], c3[16];
#pragma unroll
        for (int j = 0; j < 16; ++j) { c3[j] = (int)0x80000000; }
#pragma unroll
        for (int i = 0; i < 16; ++i)
#pragma unroll
            for (int j = 0; j < 16; ++j)
                if ((i + 1) * (j + 1) <= 16) {
                    int idx = j;
#pragma unroll
                    for (int a = 0; a < 16; ++a) if (a < i) idx += 16 / (a + 1);
                    const float val = v1[i] + v2[j]; const int key = (sortable(val) & ~255) | (i << 4) | j;
                    if (idx < 16) c0[idx] = key; else if (idx < 32) c1[idx - 16] = key; else if (idx < 48) c2[idx - 32] = key; else c3[idx - 48] = key;
                }
        bitonic_sort16_desc(c0); bitonic_sort16_desc(c1); bitonic_sort16_desc(c2); bitonic_sort16_desc(c3);
        merge_top16(c0, c1); merge_top16(c2, c3); merge_top16(c0, c2);
        int best[16];
#pragma unroll
        for (int j = 0; j < 16; ++j) best[j] = c0[j];
        unsigned char* IDXB = lds + 34816 + wid * 2048; unsigned* IDXW = (unsigned*)IDXB;
#pragma unroll
        for (int jq = 0; jq < 4; ++jq) {
            IDXW[jq * 64 + lane] = (unsigned)(top0[4 * jq] & 127) | ((unsigned)(top0[4 * jq + 1] & 127) << 8) | ((unsigned)(top0[4 * jq + 2] & 127) << 16) | ((unsigned)(top0[4 * jq + 3] & 127) << 24);
            IDXW[(4 + jq) * 64 + lane] = (unsigned)(top1[4 * jq] & 127) | ((unsigned)(top1[4 * jq + 1] & 127) << 8) | ((unsigned)(top1[4 * jq + 2] & 127) << 16) | ((unsigned)(top1[4 * jq + 3] & 127) << 24);
        }
        const float mval = unsortable(best[0] & ~255);
        float ev[16]; int ei[16]; float sum = 0.f;
#pragma unroll
        for (int kx = 0; kx < 16; ++kx) {
            const int ij = best[kx] & 255, i = ij >> 4, j = ij & 15;
            const int n1 = IDXB[((i >> 2) * 64 + lane) * 4 + (i & 3)], n2 = IDXB[((4 + (j >> 2)) * 64 + lane) * 4 + (j & 3)];
            ei[kx] = n1 * 128 + n2; ev[kx] = fast_exp((unsortable(best[kx] & ~255) - mval) * rstok); sum += ev[kx];
        }
        const float rsum = 1.f / sum;
        if (lane < 32) {
#pragma unroll
            for (int kx = 0; kx < 16; ++kx) { SELI[l31 * 128 + hd * 16 + kx] = ei[kx]; SELG[l31 * 128 + hd * 16 + kx] = ev[kx] * rsum; }
        }
    }
    }
    __syncthreads();
    if (mode != 1) {
    const unsigned char* UBq = p.ws + OFF_UB; const unsigned char* VBq = p.ws + OFF_VB; const float* SU = (const float*)(p.ws + OFF_SU); const float* SV = (const float*)(p.ws + OFF_SV);
    for (int q = 0; q < 4; ++q) {
        const int tl = 4 * wid + q; const size_t tok = (size_t)t0 + tl;
        unsigned xq[8]; float sx; float sumx;
        {
            float xf[32];
            const bf16_t* xp = XN + tok * D + 4 * lane;
#pragma unroll
            for (int i = 0; i < 8; ++i) { const u32x2 w = *(const u32x2*)(xp + 256 * i); xf[4 * i] = bf_lo(w.x); xf[4 * i + 1] = bf_hi(w.x); xf[4 * i + 2] = bf_lo(w.y); xf[4 * i + 3] = bf_hi(w.y); }
            float am = 0.f;
#pragma unroll
            for (int i = 0; i < 32; ++i) am = fmaxf(am, fabsf(xf[i]));
#pragma unroll
            for (int m = 1; m < 64; m <<= 1) am = fmaxf(am, shx(am, m));
            const float inv = am > 0.f ? 127.f / am : 0.f; sx = am * (1.f / 127.f);
            int isum = 0;
#pragma unroll
            for (int i = 0; i < 8; ++i) { const float* f = xf + 4 * i;
                const int q0 = (int)rintf(f[0] * inv), q1 = (int)rintf(f[1] * inv), q2 = (int)rintf(f[2] * inv), q3 = (int)rintf(f[3] * inv); isum += q0 + q1 + q2 + q3;
                xq[i] = (unsigned)(q0 & 0xff) | ((unsigned)(q1 & 0xff) << 8) | ((unsigned)(q2 & 0xff) << 16) | ((unsigned)(q3 & 0xff) << 24); }
            sumx = (float)isum;
#pragma unroll
            for (int m = 1; m < 64; m <<= 1) sumx += shx(sumx, m);
        }
        const int e_lo = SELI[tl * 128 + lane], e_hi = SELI[tl * 128 + 64 + lane];
        const float g_lo = SELG[tl * 128 + lane], g_hi = SELG[tl * 128 + 64 + lane];
        const float sxr = sx * RSL[tl];
        const float su_lo = SU[e_lo] * sxr, su_hi = SU[e_hi] * sxr, sv_lo = SV[e_lo], sv_hi = SV[e_hi];
        float a_lo = 0.f, a_hi = 0.f;
        u32x4 B0[8], B1[8];
        auto loadRows = [&](u32x4 (&buf)[8], const unsigned char* tab, int j) {
            const int esrc = j < 8 ? e_lo : e_hi;
#pragma unroll
            for (int i = 0; i < 8; ++i) { const int eid = __builtin_amdgcn_readlane(esrc, (j & 7) * 8 + i); buf[i] = *(const u32x4*)(tab + (size_t)eid * 1024 + 16 * lane); }
        };
        auto procU = [&](const u32x4 (&buf)[8], int j) {
            float ps[8];
#pragma unroll
            for (int i = 0; i < 8; ++i) { const u32x4 uu = buf[i]; int acc = 0;
#pragma unroll
                for (int d = 0; d < 4; ++d) { const unsigned wv = uu[d];
                    acc = __builtin_amdgcn_sdot4((int)(wv & 0x0f0f0f0fu), (int)xq[2 * d], acc, false); acc = __builtin_amdgcn_sdot4((int)((wv >> 4) & 0x0f0f0f0fu), (int)xq[2 * d + 1], acc, false); }
                ps[i] = (float)acc; }
            float q1[4], q2[2];
#pragma unroll
            for (int i = 0; i < 4; ++i) { const bool o = lane & 1; const float keep = o ? ps[2 * i + 1] : ps[2 * i], send = o ? ps[2 * i] : ps[2 * i + 1]; q1[i] = keep + shx(send, 1); }
#pragma unroll
            for (int i = 0; i < 2; ++i) { const bool o = lane & 2; const float keep = o ? q1[2 * i + 1] : q1[2 * i], send = o ? q1[2 * i] : q1[2 * i + 1]; q2[i] = keep + shx(send, 2); }
            float q3; { const bool o = lane & 4; const float keep = o ? q2[1] : q2[0], send = o ? q2[0] : q2[1]; q3 = keep + shx(send, 4); }
            q3 += shx(q3, 8); q3 += shx(q3, 16); q3 += shx(q3, 32);
            if ((lane >> 3) == (j & 7)) { if (j < 8) a_lo = q3; else a_hi = q3; }
        };
        float hh[2] = {0.f, 0.f};
        loadRows(B0, UBq, 0); loadRows(B1, UBq, 1);
#pragma unroll 1
        for (int jj = 0; jj < 16; jj += 2) {
            procU(B0, jj);     if (jj + 2 < 16) loadRows(B0, UBq, jj + 2);
            procU(B1, jj + 1); if (jj + 3 < 16) loadRows(B1, UBq, jj + 3);
        }
        a_lo -= 7.5f * sumx; a_hi -= 7.5f * sumx;
        {
            const float av[2] = {a_lo * su_lo, a_hi * su_hi}; const float gv[2] = {g_lo * sv_lo, g_hi * sv_hi};
#pragma unroll
            for (int i = 0; i < 2; ++i) { const float a = av[i]; const float y = 0.7978845608028654f * (a + 0.044715f * a * a * a);
                const float th = 1.f - 2.f * fast_rcp(1.f + fast_exp(2.f * y)); hh[i] = 0.5f * a * (1.f + th) * gv[i]; }
        }
        {
            float* HE = (float*)(p.ws + OFF_HE) + tok * 128; int* EI = (int*)(p.ws + OFF_EI) + tok * 128;
            HE[lane] = hh[0]; HE[64 + lane] = hh[1]; EI[lane] = e_lo; EI[64 + lane] = e_hi;
        }
    }
    }
    __syncthreads();
}


DI void peer_unit_B(const Params& p, int unit) {
    const int t0 = unit * 32; const int tid = threadIdx.x, lane = tid & 63, wid = tid >> 6;
    const bf16_t* XN = (const bf16_t*)(p.ws + OFF_HN); const unsigned char* VBq = p.ws + OFF_VB;
    const float* HEb = (const float*)(p.ws + OFF_HE); const int* EIb = (const int*)(p.ws + OFF_EI);
    int e_lo = EIb[((size_t)t0 + 4 * wid) * 128 + lane], e_hi = EIb[((size_t)t0 + 4 * wid) * 128 + 64 + lane];
    float h_lo = HEb[((size_t)t0 + 4 * wid) * 128 + lane], h_hi = HEb[((size_t)t0 + 4 * wid) * 128 + 64 + lane];
    u32x4 B0[8], B1[8], B2[8];
    auto loadRows = [&](u32x4 (&buf)[8], int j, int elo, int ehi) {
        const int esrc = j < 8 ? elo : ehi;
#pragma unroll
        for (int i = 0; i < 8; ++i) { const int eid = __builtin_amdgcn_readlane(esrc, (j & 7) * 8 + i); buf[i] = *(const u32x4*)(VBq + (size_t)eid * 1024 + 16 * lane); }
    };
    loadRows(B0, 0, e_lo, e_hi); loadRows(B1, 1, e_lo, e_hi); loadRows(B2, 2, e_lo, e_hi);
    for (int q = 0; q < 4; ++q) {
        const size_t tok = (size_t)t0 + 4 * wid + q; const size_t tn = (q < 3) ? tok + 1 : tok;
        const int ne_lo = EIb[tn * 128 + lane], ne_hi = EIb[tn * 128 + 64 + lane]; const float nh_lo = HEb[tn * 128 + lane], nh_hi = HEb[tn * 128 + 64 + lane];
        f32x2 acc[16];
#pragma unroll
        for (int i = 0; i < 16; ++i) acc[i] = (f32x2){0.f, 0.f};
        auto procV = [&](const u32x4 (&buf)[8], int j) {
            const float hsrc = j < 8 ? h_lo : h_hi;
#pragma unroll
            for (int i = 0; i < 8; ++i) {
                const float hv = __int_as_float(__builtin_amdgcn_readlane(__float_as_int(hsrc), (j & 7) * 8 + i));
                const f32x2 hv2 = {hv, hv}; const u32x4 vv = buf[i];
#pragma unroll
                for (int d = 0; d < 4; ++d) { const unsigned wv = vv[d];
                    acc[4 * d + 0] += hv2 * __builtin_amdgcn_cvt_scalef32_pk_f32_fp4(wv, 1.0f, 0); acc[4 * d + 1] += hv2 * __builtin_amdgcn_cvt_scalef32_pk_f32_fp4(wv, 1.0f, 1);
                    acc[4 * d + 2] += hv2 * __builtin_amdgcn_cvt_scalef32_pk_f32_fp4(wv, 1.0f, 2); acc[4 * d + 3] += hv2 * __builtin_amdgcn_cvt_scalef32_pk_f32_fp4(wv, 1.0f, 3); }
            }
        };
#pragma unroll 1
        for (int jj = 0; jj < 15; jj += 3) {
            procV(B0, jj);     if (jj + 3 < 16) loadRows(B0, jj + 3, e_lo, e_hi);
            procV(B1, jj + 1); if (jj + 4 < 16) loadRows(B1, jj + 4, e_lo, e_hi); else if (q < 3) loadRows(B1, 1, ne_lo, ne_hi);
            procV(B2, jj + 2); if (jj + 5 < 16) loadRows(B2, jj + 5, e_lo, e_hi); else if (q < 3) loadRows(B2, 2, ne_lo, ne_hi);
        }
        procV(B0, 15); if (q < 3) loadRows(B0, 0, ne_lo, ne_hi);
        float* orow = p.out + tok * D + 4 * lane; const bf16_t* hrow = XN + tok * D + 4 * lane;
#pragma unroll
        for (int i = 0; i < 8; ++i) { const u32x2 hw = *(const u32x2*)(hrow + 256 * i); f32x4 a;
            a[0] = bf_lo(hw.x) + acc[2 * i][0]; a[1] = bf_hi(hw.x) + acc[2 * i][1]; a[2] = bf_lo(hw.y) + acc[2 * i + 1][0]; a[3] = bf_hi(hw.y) + acc[2 * i + 1][1];
            __builtin_nontemporal_store(a, (f32x4*)(orow + 256 * i)); }
        e_lo = ne_lo; e_hi = ne_hi; h_lo = nh_lo; h_hi = nh_hi;
    }
}

#define XB_TMO      128
#define XB_XCNT(j)  (256  + 64 * (j))
#define XB_XSUB(j)  (1280 + 64 * (j))
#define XB_XGEN(j)  (2304 + 64 * (j))
#define XB_TOP      3328
#define XB_TOPGEN   3392
#define XCD_BAR_WORDS 3456
#define XB_SPIN_CAP (1u << 20)
DI unsigned xb_ld(unsigned* p)              { return __hip_atomic_load(p, __ATOMIC_RELAXED, __HIP_MEMORY_SCOPE_AGENT); }
DI unsigned xb_add(unsigned* p, unsigned v) { return __hip_atomic_fetch_add(p, v, __ATOMIC_RELAXED, __HIP_MEMORY_SCOPE_AGENT); }
DI unsigned xb_xcc_id() { return (unsigned)__builtin_amdgcn_s_getreg((3 << 11) | 20) & 0xFu; }
#define XB_SPIN(cond, bar) do { unsigned _sp = 0; while (cond) { __builtin_amdgcn_s_sleep(1); \
    if ((++_sp & 255u) == 0u) { if (xb_ld(&(bar)[XB_TMO])) break; if (_sp > XB_SPIN_CAP) { atomicAdd(&(bar)[XB_TMO], 1u); break; } } } } while (0)
struct XcdBarrier { unsigned* bar; unsigned x; volatile LAS unsigned* st; };
DI XcdBarrier xcd_barrier_post(unsigned* bar, volatile LAS unsigned* st) {
    XcdBarrier b; b.bar = bar; b.x = xb_xcc_id(); b.st = st;
    if (threadIdx.x == 0) (void)xb_add(&bar[XB_XCNT(b.x)], 1u);
    return b;
}
DI void xcd_barrier_complete(unsigned* bar, unsigned x, unsigned& nloc, unsigned& nx) {
    const unsigned G = gridDim.x * gridDim.y * gridDim.z;
    unsigned sum, cnt, mine, sp = 0u;
    for (;;) {
        sum = 0u; cnt = 0u; mine = 0u;
#pragma unroll
        for (unsigned j = 0; j < 16; ++j) { const unsigned c = xb_ld(&bar[XB_XCNT(j)]); sum += c; cnt += (c > 0u) ? 1u : 0u; mine = (j == x) ? c : mine; }
        if (sum == G) break;
        __builtin_amdgcn_s_sleep(1);
        if ((++sp & 255u) == 0u) { if (xb_ld(&bar[XB_TMO])) break; if (sp > XB_SPIN_CAP) { atomicAdd(&bar[XB_TMO], 1u); break; } }
    }
    nloc = mine > 0u ? mine : 1u; nx = cnt > 0u ? cnt : 1u;
}
DI void xcd_barrier(const XcdBarrier& b) {
    asm volatile("s_waitcnt vmcnt(0)" ::: "memory");
    __syncthreads();
    if (threadIdx.x == 0) {
        unsigned* bar = b.bar;
        __builtin_amdgcn_s_waitcnt(0);
        unsigned nloc = b.st[0], nx = b.st[1];
        if (nloc == 0u) { xcd_barrier_complete(bar, b.x, nloc, nx); b.st[0] = nloc; b.st[1] = nx; }
        const unsigned old = xb_add(&bar[XB_XSUB(b.x)], 1u);
        const unsigned gen = old / nloc;
        if (old + 1u == (gen + 1u) * nloc) {
            __builtin_amdgcn_fence(__ATOMIC_RELEASE, "agent");
            asm volatile("s_waitcnt vmcnt(0)" ::: "memory");
            const unsigned og = xb_add(&bar[XB_TOP], 1u);
            const unsigned tg = og / nx;
            if (og + 1u == (tg + 1u) * nx) xb_add(&bar[XB_TOPGEN], 1u);
            else XB_SPIN(xb_ld(&bar[XB_TOPGEN]) == tg, bar);
            __builtin_amdgcn_fence(__ATOMIC_ACQUIRE, "agent");
            xb_add(&bar[XB_XGEN(b.x)], 1u);
            asm volatile("s_waitcnt vmcnt(0)" ::: "memory");
        } else {
            XB_SPIN(xb_ld(&bar[XB_XGEN(b.x)]) == gen, bar);
            __builtin_amdgcn_fence(__ATOMIC_ACQUIRE, "agent");
            asm volatile("s_waitcnt vmcnt(0)" ::: "memory");
        }
    }
    __syncthreads();
}

template <int MODE>
__global__ __launch_bounds__(512, 2) void fwd_kernel(Params p) {
    extern __shared__ __attribute__((aligned(16))) unsigned char shm[];
    const int bid = blockIdx.x, nb = gridDim.x;
    XcdBarrier xb{};
    if constexpr (MODE < 0) {
        volatile LAS unsigned* st = (volatile LAS unsigned*)((LAS unsigned char*)shm + (DYN_LDS - 16));
        if (threadIdx.x == 0) { st[0] = 0u; st[1] = 0u; }
        __syncthreads();
        xb = xcd_barrier_post((unsigned*)(p.ws + OFF_XBAR), st);
    }
    if constexpr (MODE < 0 || MODE == 0) phase0(p, shm, bid, nb, 0);
    if constexpr (MODE < 0) { if (p.ws == nullptr) cg::this_grid().sync();
        xcd_barrier(xb); }
    if constexpr (MODE < 0 || MODE == 1) {
        pg8::StaticOrder S; S.init(MROWS, INC, nb, bid);
        pg8::EpiBf16 E{(bf16_t*)(p.ws + OFF_PROJ), INC, 1};
        pg8::gemm_phase((LAS unsigned char*)shm, pg8::Gemm{(const bf16_t*)(p.ws + OFF_HN), (const bf16_t*)(p.ws + OFF_WINT), MROWS, INC, D}, S, E);
    }
#if REP == 1
    if constexpr (MODE < 0) { __syncthreads();
        pg8::StaticOrder S; S.init(MROWS, INC, nb, bid);
        pg8::EpiBf16 E{(bf16_t*)(p.ws + OFF_PROJ), INC, 1};
        pg8::gemm_phase((LAS unsigned char*)shm, pg8::Gemm{(const bf16_t*)(p.ws + OFF_HN), (const bf16_t*)(p.ws + OFF_WINT), MROWS, INC, D}, S, E); }
#endif
    if constexpr (MODE < 0) xcd_barrier(xb);
    if constexpr (MODE < 0 || MODE == 2) {
        if (nb >= 128) { if (bid < 64) hgrn_item(p, shm, bid); else { for (int it = bid - 64; it < 256; it += nb - 64) attn_item(p, shm, it); phase0(p, shm, bid - 64, nb - 64, 1); } }
        else { for (int it = bid; it < 64; it += nb) hgrn_item(p, shm, it); for (int it = bid; it < 256; it += nb) attn_item(p, shm, it); phase0(p, shm, bid, nb, 1); }
    }
#if REP == 2
    if constexpr (MODE < 0) { __syncthreads(); if (bid < 64) hgrn_item(p, shm, bid); else for (int it = bid - 64; it < 256; it += nb - 64) attn_item(p, shm, it); }
#endif
    if constexpr (MODE < 0) xcd_barrier(xb);
    if constexpr (MODE < 0 || MODE == 3) {
        pg8::StaticOrder S; S.init(T, D, nb, bid);
        pg8::EpiBf16Res E{(bf16_t*)(p.ws + OFF_HN), p.x, D};
        pg8::gemm_phase((LAS unsigned char*)shm, pg8::Gemm{(const bf16_t*)(p.ws + OFF_MIX), (const bf16_t*)(p.ws + OFF_WOUTT), T, D, D}, S, E);
    }
    if constexpr (MODE < 0) xcd_barrier(xb);
    if constexpr (MODE < 0 || MODE == 5) {
        pg8::StaticOrder S; S.init(T, D, nb, bid);
        pg8::EpiBf16 E{(bf16_t*)(p.ws + OFF_PROJ), D, 0};
        pg8::gemm_phase((LAS unsigned char*)shm, pg8::Gemm{(const bf16_t*)(p.ws + OFF_HN), (const bf16_t*)(p.ws + OFF_WQT), T, D, D}, S, E);
    }
    if constexpr (MODE < 0) xcd_barrier(xb);
#if REP == 6
    if constexpr (MODE < 0) { for (int u = bid; u < T / 32; u += nb) peer_unit(p, shm, u, true); }
#endif
    if constexpr (MODE < 0 || MODE == 6) {
        if (nb == 256 && ((bid >> 3) & 1)) {
            peer_unit(p, shm, bid, 1); peer_unit(p, shm + 51200, bid + nb, 1); peer_unit(p, shm, bid, 2); peer_unit(p, shm + 51200, bid + nb, 2);
        } else { for (int u = bid; u < T / 32; u += nb) peer_unit(p, shm, u); }
    }
    if constexpr (MODE < 0 || MODE == 6) { for (int u = bid; u < T / 32; u += nb) peer_unit_B(p, u); }
}

template <int MODE> static void launch_plain(const Params& p, int grid, hipStream_t stream) {
    hipFuncSetAttribute((const void*)fwd_kernel<MODE>, hipFuncAttributeMaxDynamicSharedMemorySize, DYN_LDS);
    hipLaunchKernelGGL((fwd_kernel<MODE>), dim3(grid), dim3(512), DYN_LDS, stream, p);
}

extern "C" void kernel_launch(void* const* d_in, const int* in_sizes, int n_in, void* d_out, int out_size, void* d_ws, size_t ws_size, hipStream_t stream) {
    if (ws_size < WS_NEED) { fprintf(stderr, "workspace too small: %zu < %zu\n", ws_size, WS_NEED); return; }
    Params p{};
    p.x = (const float*)d_in[0]; p.meta = (const float*)d_in[1]; p.lb_logits = (const float*)d_in[2]; p.ln_mix_g = (const float*)d_in[3]; p.w_in = (const float*)d_in[4];
    p.q_norm_g = (const float*)d_in[5]; p.k_norm_g = (const float*)d_in[6]; p.sinks = (const float*)d_in[7]; p.hgrn_norm_g = (const float*)d_in[8]; p.w_out = (const float*)d_in[9];
    p.ln_ffn_g = (const float*)d_in[10]; p.peer_wq = (const float*)d_in[11]; p.sub_keys = (const float*)d_in[12]; p.peer_u = (const float*)d_in[13]; p.peer_v = (const float*)d_in[14];
    p.out = (float*)d_out; p.ws = (unsigned char*)d_ws;
#if MK_SINGLE
    static int grid_blocks = 0;
    if (!grid_blocks) {
        hipFuncSetAttribute((const void*)fwd_kernel<-1>, hipFuncAttributeMaxDynamicSharedMemorySize, DYN_LDS);
        int dev = 0, cus = 0, per_cu = 0; hipGetDevice(&dev); hipDeviceGetAttribute(&cus, hipDeviceAttributeMultiprocessorCount, dev);
        hipOccupancyMaxActiveBlocksPerMultiprocessor(&per_cu, fwd_kernel<-1>, 512, DYN_LDS);
        if (per_cu > 1) per_cu = 1;
        grid_blocks = cus * per_cu;
    }
    hipMemsetAsync((char*)d_ws + OFF_XBAR, 0, XCD_BAR_WORDS * 4, stream);
    void* args[] = {&p};
    hipError_t e = hipLaunchCooperativeKernel((void*)fwd_kernel<-1>, dim3(grid_blocks), dim3(512), args, DYN_LDS, stream);
    if (e != hipSuccess) fprintf(stderr, "cooperative launch failed: %s (grid %d)\n", hipGetErrorString(e), grid_blocks);
#else
    launch_plain<0>(p, 256, stream); launch_plain<1>(p, 256, stream); launch_plain<2>(p, 256, stream); launch_plain<3>(p, 256, stream);
    launch_plain<4>(p, 256, stream); launch_plain<5>(p, 256, stream); launch_plain<6>(p, 256, stream);
#endif
}
```
